# Optimizing an MI355X kernel written in HIP

```python
import jax, jax.numpy as jnp
from jax import lax
import numpy as np

D_MODEL = 1024
BATCH = 2
SEQ = 8192
DEPTH = 2

CHUNK = 64
PLE_DIM = 256
EPS = 1e-6

D_SGU = 1024
SGU_BLOCK = 128
SGU_HEADS = 8
SGU_HEAD_DIM = D_SGU // SGU_HEADS

D_CONV = 1024
CONV_WIDTH = 31

D_POOL = 1024
POOL_WINDOWS = (2, 4, 8, 16)
POOL_GROUPS = len(POOL_WINDOWS)
POOL_GROUP_DIM = D_POOL // POOL_GROUPS

N_BRANCH = 3
D_IN = 2 * D_SGU + 2 * D_CONV + D_POOL + N_BRANCH * D_MODEL
SPLITS = (2 * D_SGU, 2 * D_SGU + 2 * D_CONV, 2 * D_SGU + 2 * D_CONV + D_POOL)

D_FF = -(-8 * D_MODEL // (3 * 256)) * 256

kernel_name = "hybrid_sgu_conformer_pool_block"


def rms_norm(x, g):
    xf = x.astype(jnp.float32)
    y = xf * lax.rsqrt(jnp.mean(xf * xf, axis=-1, keepdims=True) + EPS)
    return (y * g.astype(jnp.float32)).astype(x.dtype)


def layer_norm(x, g, b):
    xf = x.astype(jnp.float32)
    mu = jnp.mean(xf, axis=-1, keepdims=True)
    xc = xf - mu
    var = jnp.mean(xc * xc, axis=-1, keepdims=True)
    y = xc * lax.rsqrt(var + EPS) * g.astype(jnp.float32) + b.astype(jnp.float32)
    return y.astype(x.dtype)


def sgu_mask():
    c = jnp.arange(SGU_BLOCK) // CHUNK
    return c[None, :] <= c[:, None]


def spatial_gating(z, w_s, b_s, g_v, b_v):
    u, v = jnp.split(z, 2, axis=-1)
    v = layer_norm(v, g_v, b_v)
    bsz, s, _ = v.shape
    nb = s // SGU_BLOCK
    v = v.reshape(bsz, nb, SGU_BLOCK, SGU_HEADS, SGU_HEAD_DIM)
    w = jnp.where(sgu_mask()[None], w_s, jnp.zeros_like(w_s))
    mixed = jnp.einsum('hij,bnjhc->bnihc', w, v) + b_s.T[None, None, :, :, None]
    return u * mixed.reshape(bsz, s, D_SGU)


def conformer_conv(z, w_dw, b_dw, g_ln, b_ln):
    a, gate = jnp.split(z, 2, axis=-1)
    h = a * jax.nn.sigmoid(gate)
    h = lax.conv_general_dilated(
        h, w_dw, window_strides=(1,), padding=((CONV_WIDTH - 1, 0),),
        dimension_numbers=('NWC', 'WIO', 'NWC'),
        feature_group_count=D_CONV) + b_dw
    h = layer_norm(h, g_ln, b_ln)
    return jax.nn.silu(h)


def multiscale_pool(z, w_pool, s_pool):
    bsz, s, _ = z.shape
    zf = z.astype(jnp.float32)
    cs = jnp.cumsum(zf, axis=1)
    t = jnp.arange(1, s + 1, dtype=jnp.float32)
    outs = []
    for gi, w in enumerate(POOL_WINDOWS):
        sl = slice(gi * POOL_GROUP_DIM, (gi + 1) * POOL_GROUP_DIM)
        c = cs[..., sl]
        prev = jnp.pad(c[:, :s - w], ((0, 0), (w, 0), (0, 0)))
        cnt = jnp.minimum(t, float(w))[None, :, None]
        outs.append((c - prev) / cnt - zf[..., sl])
    pooled = jnp.stack(outs, axis=2).astype(z.dtype)
    mixed = jnp.einsum('bsgc,gcd->bsgd', pooled, w_pool)
    return mixed.reshape(bsz, s, D_POOL) * s_pool


def setup_inputs(seed: int = 0) -> dict:
    key = jax.random.key(seed)
    ks = jax.random.split(key, 32)
    f32 = jnp.float32

    def nrm(k, shape, scale):
        return jax.random.normal(k, shape, f32) * scale

    def gain(k, shape):
        return 1.0 + 0.05 * jax.random.normal(k, shape, f32)

    L = DEPTH
    return {
        "x": nrm(ks[0], (BATCH, SEQ, D_MODEL), 1.0),
        "p": nrm(ks[1], (DEPTH, BATCH, SEQ, PLE_DIM), 1.0),
        "g_mix_pre": gain(ks[2], (L, D_MODEL)),
        "w_in": nrm(ks[3], (L, D_MODEL, D_IN), D_MODEL ** -0.5),
        "w_sgu_s": nrm(ks[4], (L, SGU_HEADS, SGU_BLOCK, SGU_BLOCK), SGU_BLOCK ** -0.5),
        "b_sgu_s": 1.0 + 0.1 * jax.random.normal(ks[5], (L, SGU_HEADS, SGU_BLOCK), f32),
        "g_sgu_v": gain(ks[6], (L, D_SGU)),
        "b_sgu_v": nrm(ks[7], (L, D_SGU), 0.02),
        "w_sgu_out": nrm(ks[8], (L, D_SGU, D_MODEL), D_SGU ** -0.5),
        "w_dw": nrm(ks[9], (L, CONV_WIDTH, 1, D_CONV), CONV_WIDTH ** -0.5),
        "b_dw": nrm(ks[10], (L, D_CONV), 0.02),
        "g_conv_ln": gain(ks[11], (L, D_CONV)),
        "b_conv_ln": nrm(ks[12], (L, D_CONV), 0.02),
        "w_conv_out": nrm(ks[13], (L, D_CONV, D_MODEL), D_CONV ** -0.5),
        "w_pool": nrm(ks[14], (L, POOL_GROUPS, POOL_GROUP_DIM, POOL_GROUP_DIM), POOL_GROUP_DIM ** -0.5),
        "s_pool": 1.0 + 0.1 * jax.random.normal(ks[15], (L, D_POOL), f32),
        "w_pool_out": nrm(ks[16], (L, D_POOL, D_MODEL), D_POOL ** -0.5),
        "w_out": nrm(ks[17], (L, D_MODEL, D_MODEL), D_MODEL ** -0.5),
        "g_mix_post": gain(ks[18], (L, D_MODEL)),
        "g_ffn_pre": gain(ks[19], (L, D_MODEL)),
        "w_ffn_in": nrm(ks[20], (L, D_MODEL, 2 * D_FF), D_MODEL ** -0.5),
        "w_ffn_out": nrm(ks[21], (L, D_FF, D_MODEL), D_FF ** -0.5),
        "g_ffn_post": gain(ks[22], (L, D_MODEL)),
        "w_ple": nrm(ks[23], (L, PLE_DIM, D_MODEL), PLE_DIM ** -0.5),
        "w_ple_gate": nrm(ks[24], (L, D_MODEL, D_MODEL), D_MODEL ** -0.5),
    }


def reference(x, p, g_mix_pre, w_in, w_sgu_s, b_sgu_s, g_sgu_v, b_sgu_v, w_sgu_out,
              w_dw, b_dw, g_conv_ln, b_conv_ln, w_conv_out, w_pool, s_pool, w_pool_out,
              w_out, g_mix_post, g_ffn_pre, w_ffn_in, w_ffn_out, g_ffn_post,
              w_ple, w_ple_gate):
    h = x
    bsz, s, _ = x.shape
    for i in range(DEPTH):
        hn = rms_norm(h, g_mix_pre[i])
        proj = hn @ w_in[i]
        z_sgu, z_conv, z_pool, z_gate = jnp.split(proj, SPLITS, axis=-1)

        br_a = spatial_gating(jax.nn.gelu(z_sgu), w_sgu_s[i], b_sgu_s[i],
                              g_sgu_v[i], b_sgu_v[i]) @ w_sgu_out[i]
        br_b = conformer_conv(z_conv, w_dw[i], b_dw[i],
                              g_conv_ln[i], b_conv_ln[i]) @ w_conv_out[i]
        br_c = multiscale_pool(z_pool, w_pool[i], s_pool[i]) @ w_pool_out[i]

        gates = jax.nn.sigmoid(z_gate).reshape(bsz, s, N_BRANCH, D_MODEL)
        merged = gates[:, :, 0] * br_a + gates[:, :, 1] * br_b + gates[:, :, 2] * br_c
        h = h + rms_norm(merged @ w_out[i], g_mix_post[i])

        hn = rms_norm(h, g_ffn_pre[i])
        f_gate, f_up = jnp.split(hn @ w_ffn_in[i], 2, axis=-1)
        f = (jax.nn.silu(f_gate) * f_up) @ w_ffn_out[i]
        h = h + rms_norm(f, g_ffn_post[i])

        h = h + jax.nn.sigmoid(h @ w_ple_gate[i]) * (p[i] @ w_ple[i])
    return h
```

```cpp
#include <hip/hip_runtime.h>
#include <cstdio>
#include <cstdint>

#ifndef MK_ONE_LAUNCH
#define MK_ONE_LAUNCH 1
#endif

namespace pg8 {
#define PG8_LAS __attribute__((address_space(3)))
typedef unsigned short bf16_t;
typedef short bf16x8 __attribute__((ext_vector_type(8)));
typedef float f32x4 __attribute__((ext_vector_type(4)));
typedef unsigned u32x4 __attribute__((ext_vector_type(4)));
constexpr int BM = 256, BK = 64, HALF = 128, HTB = HALF * BK * 2, STAGE_BYTES = 8 * HTB, NXCD = 8, WGM = 8;

__host__ __device__ __forceinline__ int lds_byte(int r, int c) { const int st = (r >> 4) * 2 + (c >> 5), rr = r & 15, cc = c & 31, ob = rr * 64 + cc * 2; return st * 1024 + (ob ^ (((ob >> 9) & 1) << 5)); }
__host__ __device__ __forceinline__ void stage_rc(int b, int& R, int& C) { const int st = b / 1024, sb = b % 1024, swz = sb ^ (((sb >> 9) & 1) << 5); R = (st >> 1) * 16 + swz / 64; C = (st & 1) * 32 + (swz % 64) / 2; }
__host__ __device__ __forceinline__ int perm32(int rho) { const int n = rho >> 4, i = rho & 15; return 8 * (i >> 2) + 4 * n + (i & 3); }

struct Unit { int pm, pn; };
struct Gemm { const bf16_t* A0; const bf16_t* A1; const bf16_t* A2; const bf16_t* Bt; int lda, ldb, M, N, K, a_pn_off; };

struct StaticOrder {
    int nM, nN, nwg, G, c;
    __host__ __device__ void init(int M, int N, int G_, int c_) { nM = M / BM; nN = N / BM; nwg = nM * nN; G = G_; c = c_; }
    __host__ __device__ bool next(int i, Unit& u) const {
        const long L = (long)i * G + c; if (L >= nwg) return false;
        int wgid = (int)L; { const int q = nwg / NXCD, r = nwg % NXCD, xcd = wgid % NXCD, off = wgid / NXCD; wgid = (xcd < r ? xcd * (q + 1) : r * (q + 1) + (xcd - r) * q) + off; }
        const int nig = WGM * nN, gid = wgid / nig, fm = gid * WGM, gsz = (nM - fm) < WGM ? (nM - fm) : WGM;
        u.pm = fm + ((wgid % nig) % gsz); u.pn = (wgid % nig) / gsz; return true;
    }
};

__device__ __forceinline__ unsigned cvt_pk_bf16(float lo, float hi) { unsigned r; asm volatile("v_cvt_pk_bf16_f32 %0, %1, %2" : "=v"(r) : "v"(lo), "v"(hi)); return r; }
__device__ __forceinline__ u32x4 pack8(const f32x4& a, const f32x4& b) { u32x4 w; w.x = cvt_pk_bf16(a[0], a[1]); w.y = cvt_pk_bf16(a[2], a[3]); w.z = cvt_pk_bf16(b[0], b[1]); w.w = cvt_pk_bf16(b[2], b[3]); return w; }
__device__ __forceinline__ void unpack8(const u32x4& w, f32x4& a, f32x4& b) {
    a[0] = __uint_as_float(w.x << 16); a[1] = __uint_as_float(w.x & 0xffff0000u); a[2] = __uint_as_float(w.y << 16); a[3] = __uint_as_float(w.y & 0xffff0000u);
    b[0] = __uint_as_float(w.z << 16); b[1] = __uint_as_float(w.z & 0xffff0000u); b[2] = __uint_as_float(w.w << 16); b[3] = __uint_as_float(w.w & 0xffff0000u); }
__device__ __forceinline__ float sigmoidf_fast(float x) { return __builtin_amdgcn_rcpf(1.0f + __builtin_amdgcn_exp2f(-1.4426950409f * x)); }
__device__ __forceinline__ float gelu_tanh(float x) { return x * sigmoidf_fast(1.5957691216f * x * (1.0f + 0.044715f * x * x)); }
__device__ __forceinline__ f32x4 sig4(f32x4 v) { f32x4 o; o[0] = sigmoidf_fast(v[0]); o[1] = sigmoidf_fast(v[1]); o[2] = sigmoidf_fast(v[2]); o[3] = sigmoidf_fast(v[3]); return o; }
__device__ __forceinline__ f32x4 gelu4(f32x4 v) { f32x4 o; o[0] = gelu_tanh(v[0]); o[1] = gelu_tanh(v[1]); o[2] = gelu_tanh(v[2]); o[3] = gelu_tanh(v[3]); return o; }

typedef f32x4 Acc[2][2][4][2];

struct EpiG1a {
    static constexpr bool PERM = true, AFTER_DRAIN = false;
    bf16_t *U, *V, *HC, *ZP; const float* rs;
    __device__ __forceinline__ void mid(Acc&, const Unit&, int, int, int, int, int) const {}
    __device__ __forceinline__ void operator()(const Acc& acc, const Unit& u, int wr, int wc, int fr, int fq) const {
        const int row0 = u.pm * BM + wr * 64 + fr, pn = u.pn;
        if (pn < 8) {
            bf16_t* base = (pn < 4 ? U : V) + (pn & 3) * 256 + wc * 32 + 8 * fq;
#pragma unroll
            for (int ai = 0; ai < 2; ++ai)
#pragma unroll
                for (int m = 0; m < 4; ++m) { const int row = row0 + ai * HALF + m * 16; const float r = rs[row]; bf16_t* rowp = base + (size_t)row * 1024;
#pragma unroll
                    for (int bj = 0; bj < 2; ++bj) { const f32x4 v0 = gelu4(acc[ai][bj][m][0] * r), v1 = gelu4(acc[ai][bj][m][1] * r); *(u32x4*)(rowp + bj * HALF) = pack8(v0, v1); } }
        } else if (pn < 16) {
            bf16_t* base = HC + (pn - 8) * 128 + wc * 32 + 8 * fq;
#pragma unroll
            for (int ai = 0; ai < 2; ++ai)
#pragma unroll
                for (int m = 0; m < 4; ++m) { const int row = row0 + ai * HALF + m * 16; const float r = rs[row]; bf16_t* rowp = base + (size_t)row * 1024;
                    const f32x4 v0 = (acc[ai][0][m][0] * r) * sig4(acc[ai][1][m][0] * r), v1 = (acc[ai][0][m][1] * r) * sig4(acc[ai][1][m][1] * r);
                    *(u32x4*)(rowp) = pack8(v0, v1); }
        } else {
            bf16_t* base = ZP + (pn - 16) * 256 + wc * 32 + 8 * fq;
#pragma unroll
            for (int ai = 0; ai < 2; ++ai)
#pragma unroll
                for (int m = 0; m < 4; ++m) { const int row = row0 + ai * HALF + m * 16; const float r = rs[row]; bf16_t* rowp = base + (size_t)row * 1024;
#pragma unroll
                    for (int bj = 0; bj < 2; ++bj) { const f32x4 v0 = acc[ai][bj][m][0] * r, v1 = acc[ai][bj][m][1] * r; *(u32x4*)(rowp + bj * HALF) = pack8(v0, v1); } }
        }
    }
};
struct EpiGate {
    static constexpr bool PERM = true, AFTER_DRAIN = false;
    bf16_t* G; const float* rs; size_t tstride;
    __device__ __forceinline__ void mid(Acc&, const Unit&, int, int, int, int, int) const {}
    __device__ __forceinline__ void operator()(const Acc& acc, const Unit& u, int wr, int wc, int fr, int fq) const {
        const int row0 = u.pm * BM + wr * 64 + fr;
        bf16_t* base = G + (size_t)(u.pn >> 2) * tstride + (u.pn & 3) * 256 + wc * 32 + 8 * fq;
#pragma unroll
        for (int ai = 0; ai < 2; ++ai)
#pragma unroll
            for (int m = 0; m < 4; ++m) { const int row = row0 + ai * HALF + m * 16; const float r = rs[row]; bf16_t* rowp = base + (size_t)row * 1024;
#pragma unroll
                for (int bj = 0; bj < 2; ++bj) { const f32x4 v0 = sig4(acc[ai][bj][m][0] * r), v1 = sig4(acc[ai][bj][m][1] * r); *(u32x4*)(rowp + bj * HALF) = pack8(v0, v1); } }
    }
};
struct EpiBf16 {
    static constexpr bool PERM = true, AFTER_DRAIN = false;
    bf16_t* O; int ldc;
    __device__ __forceinline__ void mid(Acc&, const Unit&, int, int, int, int, int) const {}
    __device__ __forceinline__ void operator()(const Acc& acc, const Unit& u, int wr, int wc, int fr, int fq) const {
        const int row0 = u.pm * BM + wr * 64 + fr;
        bf16_t* base = O + u.pn * 256 + wc * 32 + 8 * fq;
#pragma unroll
        for (int ai = 0; ai < 2; ++ai)
#pragma unroll
            for (int m = 0; m < 4; ++m) { bf16_t* rowp = base + (size_t)(row0 + ai * HALF + m * 16) * ldc;
#pragma unroll
                for (int bj = 0; bj < 2; ++bj) *(u32x4*)(rowp + bj * HALF) = pack8(acc[ai][bj][m][0], acc[ai][bj][m][1]); }
    }
};
struct EpiF32 {
    static constexpr bool PERM = true, AFTER_DRAIN = false;
    float* Y; int ldc;
    __device__ __forceinline__ void mid(Acc&, const Unit&, int, int, int, int, int) const {}
    __device__ __forceinline__ void operator()(const Acc& acc, const Unit& u, int wr, int wc, int fr, int fq) const {
        const int row0 = u.pm * BM + wr * 64 + fr;
        float* base = Y + u.pn * 256 + wc * 32 + 8 * fq;
#pragma unroll
        for (int ai = 0; ai < 2; ++ai)
#pragma unroll
            for (int m = 0; m < 4; ++m) { float* rowp = base + (size_t)(row0 + ai * HALF + m * 16) * ldc;
#pragma unroll
                for (int bj = 0; bj < 2; ++bj) { *(f32x4*)(rowp + bj * HALF) = acc[ai][bj][m][0]; *(f32x4*)(rowp + bj * HALF + 4) = acc[ai][bj][m][1]; } }
    }
};
struct EpiSwiGLU {
    static constexpr bool PERM = true, AFTER_DRAIN = false;
    bf16_t* Fo; int ldc; const float* rs;
    __device__ __forceinline__ void mid(Acc&, const Unit&, int, int, int, int, int) const {}
    __device__ __forceinline__ void operator()(const Acc& acc, const Unit& u, int wr, int wc, int fr, int fq) const {
        const int row0 = u.pm * BM + wr * 64 + fr;
        bf16_t* base = Fo + u.pn * 128 + wc * 32 + 8 * fq;
#pragma unroll
        for (int ai = 0; ai < 2; ++ai)
#pragma unroll
            for (int m = 0; m < 4; ++m) { const int row = row0 + ai * HALF + m * 16; const float r = rs[row]; bf16_t* rowp = base + (size_t)row * ldc;
                const f32x4 g0 = acc[ai][0][m][0] * r, g1 = acc[ai][0][m][1] * r;
                const f32x4 v0 = g0 * sig4(g0) * (acc[ai][1][m][0] * r), v1 = g1 * sig4(g1) * (acc[ai][1][m][1] * r);
                *(u32x4*)(rowp) = pack8(v0, v1); }
    }
};
struct EpiMerged {
    static constexpr bool PERM = true, AFTER_DRAIN = false;
    bf16_t* O; const bf16_t* G; size_t tstride;
    __device__ __forceinline__ void mid(Acc& acc, const Unit& u, int seg, int wr, int wc, int fr, int fq) const {
        const int row0 = u.pm * BM + wr * 64 + fr;
        const bf16_t* gp = G + (size_t)(seg - 1) * tstride + u.pn * 256 + wc * 32 + 8 * fq; const bf16_t* gc = gp + tstride;
#pragma unroll
        for (int ai = 0; ai < 2; ++ai)
#pragma unroll
            for (int m = 0; m < 4; ++m) { const size_t ro = (size_t)(row0 + ai * HALF + m * 16) * 1024;
#pragma unroll
                for (int bj = 0; bj < 2; ++bj) { const u32x4 wp = *(const u32x4*)(gp + ro + bj * HALF), wq = *(const u32x4*)(gc + ro + bj * HALF);
                    f32x4 p0, p1, c0, c1; unpack8(wp, p0, p1); unpack8(wq, c0, c1);
#pragma unroll
                    for (int j = 0; j < 4; ++j) { acc[ai][bj][m][0][j] *= p0[j] * __builtin_amdgcn_rcpf(c0[j]); acc[ai][bj][m][1][j] *= p1[j] * __builtin_amdgcn_rcpf(c1[j]); } } }
    }
    __device__ __forceinline__ void operator()(const Acc& acc, const Unit& u, int wr, int wc, int fr, int fq) const {
        const int row0 = u.pm * BM + wr * 64 + fr;
        const bf16_t* g2 = G + 2 * tstride + u.pn * 256 + wc * 32 + 8 * fq;
        bf16_t* base = O + u.pn * 256 + wc * 32 + 8 * fq;
#pragma unroll
        for (int ai = 0; ai < 2; ++ai)
#pragma unroll
            for (int m = 0; m < 4; ++m) { const size_t ro = (size_t)(row0 + ai * HALF + m * 16) * 1024;
#pragma unroll
                for (int bj = 0; bj < 2; ++bj) { const u32x4 wg = *(const u32x4*)(g2 + ro + bj * HALF); f32x4 a, b; unpack8(wg, a, b);
                    *(u32x4*)(base + ro + bj * HALF) = pack8(acc[ai][bj][m][0] * a, acc[ai][bj][m][1] * b); } }
    }
};
struct EpiPle {
    static constexpr bool PERM = true, AFTER_DRAIN = false;
    float* H; const bf16_t* Q;
    __device__ __forceinline__ void mid(Acc&, const Unit&, int, int, int, int, int) const {}
    __device__ __forceinline__ void operator()(const Acc& acc, const Unit& u, int wr, int wc, int fr, int fq) const {
        const int row0 = u.pm * BM + wr * 64 + fr; const int col0 = u.pn * 256 + wc * 32 + 8 * fq;
#pragma unroll
        for (int ai = 0; ai < 2; ++ai)
#pragma unroll
            for (int m = 0; m < 4; ++m) { const size_t ro = (size_t)(row0 + ai * HALF + m * 16) * 1024 + col0;
#pragma unroll
                for (int bj = 0; bj < 2; ++bj) { const u32x4 wq = *(const u32x4*)(Q + ro + bj * HALF); f32x4 q0, q1; unpack8(wq, q0, q1);
                    float* hp = H + ro + bj * HALF; const f32x4 h0 = *(const f32x4*)hp, h1 = *(const f32x4*)(hp + 4);
                    *(f32x4*)hp = h0 + sig4(acc[ai][bj][m][0]) * q0; *(f32x4*)(hp + 4) = h1 + sig4(acc[ai][bj][m][1]) * q1; } }
    }
};

__device__ __forceinline__ const char* a_addr(const Gemm& g, bool seg3, int pm, int pn, int t, size_t tstepA) {
    if (seg3) { const bf16_t* b = t < 16 ? g.A0 : (t < 32 ? g.A1 : g.A2); return (const char*)b + (size_t)pm * tstepA + (size_t)(t & 15) * (BK * 2); }
    return (const char*)g.A0 + (size_t)pm * tstepA + (size_t)pn * g.a_pn_off * 2 + (size_t)t * (BK * 2);
}

template <class Epi, bool ALIGN_EPI, bool SEG3>
__device__ __forceinline__ void gemm_phase(PG8_LAS unsigned char* lds, const Gemm g, const StaticOrder& S, const Epi& E, const int tid) {
    const int wid = __builtin_amdgcn_readfirstlane(tid >> 6), lane = tid & 63, wr = wid >> 2, wc = wid & 3, fr = lane & 15, fq = lane >> 4;
    const int K = g.K, nt = K / BK;
    unsigned voffA[2], voffB[2];
#pragma unroll
    for (int i = 0; i < 2; ++i) { int R, C; stage_rc(tid * 16 + i * 8192, R, C); const int Rb = Epi::PERM ? ((R & ~31) + perm32(R & 31)) : R;
        voffA[i] = (unsigned)(R * g.lda + C) * 2u; voffB[i] = (unsigned)(Rb * g.ldb + C) * 2u; }
    const size_t kstep = (size_t)(BK * 2);
    const size_t hstepA = (size_t)HALF * g.lda * 2, hstepB = (size_t)HALF * g.ldb * 2;
    const size_t tstepA = 2 * hstepA, tstepB = 2 * hstepB;
    const unsigned ldsw = (unsigned)wid * 1024u;
    const int aoff = lds_byte(wr * 64 + fr, fq * 8), boff = lds_byte(wc * 32 + fr, fq * 8);
#define PG8_SA(b, h) (((b) * 2 + (h)) * HTB)
#define PG8_SB(b, h) ((4 + (b) * 2 + (h)) * HTB)
#define PG8_STAGE(bufoff, gbase, voff) do { _Pragma("unroll") for (int _i = 0; _i < 2; ++_i) \
        __builtin_amdgcn_global_load_lds((const unsigned*)((const char*)(gbase) + (voff)[_i]), (PG8_LAS unsigned*)(lds + (bufoff) + ldsw + _i * 8192), 16, 0, 0); } while (0)
#define PG8_LDA(dst, b, h) do { _Pragma("unroll") for (int m = 0; m < 4; ++m) _Pragma("unroll") for (int k = 0; k < 2; ++k) dst[m][k] = *(const PG8_LAS bf16x8*)(lds + PG8_SA(b, h) + aoff + m * 2048 + k * 1024); } while (0)
#define PG8_LDB(dst, b, h) do { _Pragma("unroll") for (int n = 0; n < 2; ++n) _Pragma("unroll") for (int k = 0; k < 2; ++k) dst[n][k] = *(const PG8_LAS bf16x8*)(lds + PG8_SB(b, h) + boff + n * 2048 + k * 1024); } while (0)
#define PG8_MMA(ai, bj, At, Bt) do { __builtin_amdgcn_s_setprio(1); _Pragma("unroll") for (int m = 0; m < 4; ++m) _Pragma("unroll") for (int n = 0; n < 2; ++n) _Pragma("unroll") for (int k = 0; k < 2; ++k) \
        acc[ai][bj][m][n] = __builtin_amdgcn_mfma_f32_16x16x32_bf16(Bt[n][k], At[m][k], acc[ai][bj][m][n], 0, 0, 0); __builtin_amdgcn_s_setprio(0); } while (0)
#define PG8_WAIT_V(n) asm volatile("s_waitcnt vmcnt(" #n ")" ::: "memory")
#define PG8_WAIT_L(n) asm volatile("s_waitcnt lgkmcnt(" #n ")" ::: "memory")
#define PG8_BAR __builtin_amdgcn_s_barrier()
#define PG8_SCHED __builtin_amdgcn_sched_barrier(0)
    Unit cur, nxt; int ui = 0;
    if (!S.next(0, cur)) return;
    Acc acc;
#pragma unroll
    for (int a = 0; a < 2; ++a)
#pragma unroll
        for (int b = 0; b < 2; ++b)
#pragma unroll
            for (int m = 0; m < 4; ++m)
#pragma unroll
                for (int n = 0; n < 2; ++n) acc[a][b][m][n] = (f32x4){0.f, 0.f, 0.f, 0.f};
    bf16x8 At[4][2], B0[2][2], B1[2][2];
    const char* cB = (const char*)g.Bt + (size_t)cur.pn * tstepB;
    {
        const char* cA0 = a_addr(g, SEG3, cur.pm, cur.pn, 0, tstepA); const char* cA1 = a_addr(g, SEG3, cur.pm, cur.pn, 1, tstepA);
        PG8_STAGE(PG8_SB(0, 0), cB, voffB); PG8_STAGE(PG8_SB(0, 1), cB + hstepB, voffB); PG8_STAGE(PG8_SA(0, 0), cA0, voffA); PG8_STAGE(PG8_SA(0, 1), cA0 + hstepA, voffA);
        if (wr == 1) PG8_BAR;
        PG8_WAIT_V(2); PG8_BAR;
        PG8_STAGE(PG8_SB(1, 0), cB + kstep, voffB); PG8_STAGE(PG8_SA(1, 0), cA1, voffA); PG8_STAGE(PG8_SB(1, 1), cB + hstepB + kstep, voffB);
        PG8_WAIT_V(6); PG8_BAR;
    }
    for (;;) {
        const bool has_next = S.next(ui + 1, nxt);
        const Unit nu = has_next ? nxt : cur;
        const char* nB = (const char*)g.Bt + (size_t)nu.pn * tstepB;
        for (int t = 0; t < nt; t += 2) {
            const bool last = (t == nt - 2);
            if (SEG3 && (t == 16 || t == 32)) E.mid(acc, cur, t >> 4, wr, wc, fr, fq);
            const char* a1 = a_addr(g, SEG3, cur.pm, cur.pn, t + 1, tstepA);
            const char* a2 = last ? a_addr(g, SEG3, nu.pm, nu.pn, 0, tstepA) : a_addr(g, SEG3, cur.pm, cur.pn, t + 2, tstepA);
            const char* a3 = last ? a_addr(g, SEG3, nu.pm, nu.pn, 1, tstepA) : a_addr(g, SEG3, cur.pm, cur.pn, t + 3, tstepA);
            const char* b2 = last ? nB : cB + (size_t)(t + 2) * kstep; const char* b3 = b2 + kstep;
            PG8_LDB(B0, 0, 0); PG8_LDB(B1, 0, 1); PG8_SCHED; PG8_LDA(At, 0, 0); PG8_STAGE(PG8_SA(1, 1), a1 + hstepA, voffA);
            PG8_WAIT_V(8); PG8_WAIT_L(0); PG8_BAR; PG8_MMA(0, 0, At, B0); PG8_MMA(0, 1, At, B1); PG8_BAR; PG8_SCHED;
            PG8_LDA(At, 0, 1); PG8_STAGE(PG8_SB(0, 0), b2, voffB); PG8_STAGE(PG8_SB(0, 1), b2 + hstepB, voffB); PG8_STAGE(PG8_SA(0, 0), a2, voffA);
            PG8_WAIT_V(8); PG8_WAIT_L(0); PG8_BAR; PG8_MMA(1, 0, At, B0); PG8_MMA(1, 1, At, B1); PG8_BAR; PG8_SCHED;
            PG8_LDB(B0, 1, 0); PG8_LDB(B1, 1, 1); PG8_SCHED; PG8_LDA(At, 1, 0); PG8_STAGE(PG8_SA(0, 1), a2 + hstepA, voffA);
            PG8_WAIT_V(8); PG8_WAIT_L(0); PG8_BAR; PG8_MMA(0, 0, At, B0); PG8_MMA(0, 1, At, B1); PG8_BAR; PG8_SCHED;
            PG8_LDA(At, 1, 1); PG8_STAGE(PG8_SB(1, 0), b3, voffB); PG8_STAGE(PG8_SB(1, 1), b3 + hstepB, voffB); PG8_STAGE(PG8_SA(1, 0), a3, voffA);
            PG8_WAIT_V(8); PG8_WAIT_L(0); PG8_BAR; PG8_MMA(1, 0, At, B0); PG8_MMA(1, 1, At, B1); PG8_BAR; PG8_SCHED;
        }
        if constexpr (ALIGN_EPI) { if (wr == 0) PG8_BAR; }
        E(acc, cur, wr, wc, fr, fq);
        if (!has_next) break;
#pragma unroll
        for (int a = 0; a < 2; ++a)
#pragma unroll
            for (int b = 0; b < 2; ++b)
#pragma unroll
                for (int m = 0; m < 4; ++m)
#pragma unroll
                    for (int n = 0; n < 2; ++n) acc[a][b][m][n] = (f32x4){0.f, 0.f, 0.f, 0.f};
        cur = nxt; cB = nB; ++ui;
        if constexpr (ALIGN_EPI) { if (wr == 1) PG8_BAR; }
    }
    PG8_WAIT_V(0);
    if constexpr (!ALIGN_EPI) { if (wr == 0) PG8_BAR; }
    PG8_BAR;
#undef PG8_SA
#undef PG8_SB
#undef PG8_STAGE
#undef PG8_LDA
#undef PG8_LDB
#undef PG8_MMA
#undef PG8_WAIT_V
#undef PG8_WAIT_L
#undef PG8_BAR
#undef PG8_SCHED
}
}

constexpr int NWAVES = 8;
constexpr int BATCH = 2, SEQ = 8192, D = 1024, M = BATCH * SEQ, DEPTH = 2, PLED = 256, DFF = 2816, NIN = 8192;
constexpr float EPS = 1e-6f;
constexpr int N_IN = 25;
enum { I_X = 0, I_P, I_GMIXPRE, I_WIN, I_WSGUS, I_BSGUS, I_GSGUV, I_BSGUV, I_WSGUOUT, I_WDW, I_BDW, I_GCONVLN, I_BCONVLN, I_WCONVOUT, I_WPOOL, I_SPOOL, I_WPOOLOUT,
       I_WOUT, I_GMIXPOST, I_GFFNPRE, I_WFFNIN, I_WFFNOUT, I_GFFNPOST, I_WPLE, I_WPLEGATE };

constexpr size_t MiB = 1u << 20, KiB = 1024;
constexpr size_t WS_CTL = 0, CTL_ZERO_BYTES = 256 * KiB;
constexpr size_t WS_W = 1 * MiB;
constexpr size_t WS_W1A = WS_W, WS_W1B = WS_W + 10 * MiB, WS_WMIX = WS_W + 16 * MiB, WS_WOUT = WS_W + 22 * MiB, WS_WF1 = WS_W + 24 * MiB, WS_WF2 = WS_W + 35 * MiB,
                 WS_WPG = WS_WF2 + (size_t)D * DFF * 2, WS_WPLE = WS_WPG + 2 * MiB, WS_WPL = WS_WPLE + 512 * KiB, WS_WSGU = WS_WPL + 512 * KiB;
static_assert(WS_WSGU + 256 * KiB <= 45 * MiB, "weight region");
constexpr size_t SLOT = 32 * MiB;
constexpr size_t WS_HB0 = 45 * MiB, WS_S0 = WS_HB0 + SLOT, WS_S1 = WS_S0 + SLOT, WS_S2 = WS_S1 + SLOT, WS_S3 = WS_S2 + SLOT, WS_S4 = WS_S3 + SLOT, WS_S5 = WS_S4 + SLOT;
constexpr size_t WS_MISC = WS_S5 + SLOT;
constexpr size_t WS_RS = WS_MISC, WS_RS2 = WS_MISC + 64 * KiB, WS_VST = WS_MISC + 128 * KiB;
constexpr size_t WS_END = WS_MISC + 2 * MiB;
static_assert(WS_END <= 284508160ull, "workspace map exceeds the guaranteed d_ws size");

constexpr int RING_BYTES = 131072;
constexpr int LDSCTL_OFF = RING_BYTES, MISC_OFF = LDSCTL_OFF + 320;
constexpr int LDS_BYTES = 147456;

#define GAS __attribute__((address_space(1)))
#define LAS __attribute__((address_space(3)))
typedef unsigned short bf16;
typedef unsigned v4u __attribute__((ext_vector_type(4)));
typedef unsigned v2u __attribute__((ext_vector_type(2)));
typedef float f32x4 __attribute__((ext_vector_type(4)));
typedef float f32x2 __attribute__((ext_vector_type(2)));
typedef GAS unsigned gu32;
#define RLX_AGENT __ATOMIC_RELAXED, __HIP_MEMORY_SCOPE_AGENT
#define LDS_WAIT() asm volatile("s_waitcnt lgkmcnt(0)" ::: "memory")
#define VM_WAIT() asm volatile("s_waitcnt vmcnt(0)" ::: "memory")
__device__ __forceinline__ unsigned f2bf(float f) { unsigned u = __builtin_bit_cast(unsigned, f); return (u + 0x7fffu + ((u >> 16) & 1u)) >> 16; }
__device__ __forceinline__ unsigned pk2(float lo, float hi) { return f2bf(lo) | (f2bf(hi) << 16); }
__device__ __forceinline__ float bflo(unsigned w) { return __uint_as_float(w << 16); }
__device__ __forceinline__ float bfhi(unsigned w) { return __uint_as_float(w & 0xffff0000u); }

#define XB_TMO      128
#define XB_XCNT(j)  (256  + 64 * (j))
#define XB_XSUB(j)  (1280 + 64 * (j))
#define XB_XGEN(j)  (2304 + 64 * (j))
#define XB_TOP      3328
#define XB_TOPGEN   3392
#define XCD_BAR_WORDS 3456
#define XB_SPIN_CAP (1u << 22)
constexpr int CW_BAR = 4096;
__device__ __forceinline__ unsigned xb_ld(unsigned* p)              { return __hip_atomic_load(p, __ATOMIC_RELAXED, __HIP_MEMORY_SCOPE_AGENT); }
__device__ __forceinline__ unsigned xb_add(unsigned* p, unsigned v) { return __hip_atomic_fetch_add(p, v, __ATOMIC_RELAXED, __HIP_MEMORY_SCOPE_AGENT); }
__device__ __forceinline__ unsigned xb_xcc_id() { return (unsigned)__builtin_amdgcn_s_getreg((3 << 11) | 20) & 0xFu; }
#define XB_SPIN(cond, bar) do { unsigned _sp = 0; while (cond) { __builtin_amdgcn_s_sleep(1); \
    if ((++_sp & 255u) == 0u) { if (xb_ld(&(bar)[XB_TMO])) break; if (_sp > XB_SPIN_CAP) { atomicAdd(&(bar)[XB_TMO], 1u); break; } } } } while (0)
struct XcdBarrier { unsigned* bar; unsigned x; volatile LAS unsigned* st; };
__device__ __forceinline__ XcdBarrier xcd_barrier_post(unsigned* bar, volatile LAS unsigned* st) {
    XcdBarrier b; b.bar = bar; b.x = xb_xcc_id(); b.st = st;
    if (threadIdx.x == 0) (void)xb_add(&bar[XB_XCNT(b.x)], 1u);
    return b;
}
__device__ __forceinline__ void xcd_barrier_complete(unsigned* bar, unsigned x, unsigned& nloc, unsigned& nx) {
    const unsigned G = gridDim.x * gridDim.y * gridDim.z;
    unsigned sum, cnt, mine, sp = 0u;
    for (;;) {
        sum = 0u; cnt = 0u; mine = 0u;
#pragma unroll
        for (unsigned j = 0; j < 16; ++j) { const unsigned c = xb_ld(&bar[XB_XCNT(j)]); sum += c; cnt += (c > 0u) ? 1u : 0u; mine = (j == x) ? c : mine; }
        if (sum == G) break;
        __builtin_amdgcn_s_sleep(1);
        if ((++sp & 255u) == 0u) { if (xb_ld(&bar[XB_TMO])) break; if (sp > XB_SPIN_CAP) { atomicAdd(&bar[XB_TMO], 1u); break; } }
    }
    nloc = mine > 0u ? mine : 1u; nx = cnt > 0u ? cnt : 1u;
}
__device__ __forceinline__ void xcd_barrier(const XcdBarrier& b) {
    asm volatile("s_waitcnt vmcnt(0)" ::: "memory");
    __syncthreads();
    if (threadIdx.x == 0) {
        unsigned* bar = b.bar;
        __builtin_amdgcn_s_waitcnt(0);
        unsigned nloc = b.st[0], nx = b.st[1];
        if (nloc == 0u) { xcd_barrier_complete(bar, b.x, nloc, nx); b.st[0] = nloc; b.st[1] = nx; }
        const unsigned old = xb_add(&bar[XB_XSUB(b.x)], 1u);
        const unsigned gen = old / nloc;
        if (old + 1u == (gen + 1u) * nloc) {
            __builtin_amdgcn_fence(__ATOMIC_RELEASE, "agent");
            asm volatile("s_waitcnt vmcnt(0)" ::: "memory");
            const unsigned og = xb_add(&bar[XB_TOP], 1u);
            const unsigned tg = og / nx;
            if (og + 1u == (tg + 1u) * nx) xb_add(&bar[XB_TOPGEN], 1u);
            else XB_SPIN(xb_ld(&bar[XB_TOPGEN]) == tg, bar);
            __builtin_amdgcn_fence(__ATOMIC_ACQUIRE, "agent");
            xb_add(&bar[XB_XGEN(b.x)], 1u);
            asm volatile("s_waitcnt vmcnt(0)" ::: "memory");
        } else {
            XB_SPIN(xb_ld(&bar[XB_XGEN(b.x)]) == gen, bar);
            __builtin_amdgcn_fence(__ATOMIC_ACQUIRE, "agent");
            asm volatile("s_waitcnt vmcnt(0)" ::: "memory");
        }
    }
    __syncthreads();
}

struct Frame {
    LAS unsigned char* lds;
    volatile LAS unsigned* MISC;
    gu32* ctl;
    int tid, lane, wave;
    int vcu, G;
    const float* in[N_IN];
    float* out;
    unsigned char* ws;
};
__device__ __forceinline__ float wave_sum(float v) {
#pragma unroll
    for (int o = 1; o < 64; o <<= 1) v += __shfl_xor(v, o);
    return v;
}

__device__ __forceinline__ void tr_item(const float* W, int ldw, int k0, int scol0, bf16* WT, int ldt, int drow0, int dk0, const float* ks, const float* ns, LAS float* scr, int lane) {
#pragma unroll 8
    for (int i = 0; i < 32; ++i) { const int kk = 2 * i + (lane >> 5); float v = W[(size_t)(k0 + kk) * ldw + scol0 + (lane & 31)]; if (ks) v *= ks[k0 + kk]; scr[kk * 33 + (lane & 31)] = v; }
    LDS_WAIT(); asm volatile("" ::: "memory");
    const int c = lane & 7;
#pragma unroll
    for (int j = 0; j < 4; ++j) { const int n = (lane >> 3) + 8 * j; const LAS float* s = scr + (8 * c) * 33 + n; const float sc = ns ? ns[drow0 + n] : 1.0f;
        v4u o; o.x = pk2(s[0 * 33] * sc, s[1 * 33] * sc); o.y = pk2(s[2 * 33] * sc, s[3 * 33] * sc); o.z = pk2(s[4 * 33] * sc, s[5 * 33] * sc); o.w = pk2(s[6 * 33] * sc, s[7 * 33] * sc);
        *(v4u*)(WT + (size_t)(drow0 + n) * ldt + dk0 + k0 + 8 * c) = o; }
    LDS_WAIT(); asm volatile("" ::: "memory");
}
__device__ __forceinline__ void row_to_bf16_rs(const float* xrow, bf16* orow, float* rs, int lane) {
    const f32x4* xr = (const f32x4*)xrow + lane;
    f32x4 v[4]; float s = 0.f;
#pragma unroll
    for (int j = 0; j < 4; ++j) { v[j] = xr[64 * j]; s += (v[j].x * v[j].x + v[j].y * v[j].y) + (v[j].z * v[j].z + v[j].w * v[j].w); }
    s = wave_sum(s);
    if (rs && lane == 0) *rs = 1.0f / sqrtf(s * (1.f / D) + EPS);
    unsigned long long* o8 = (unsigned long long*)orow + lane;
#pragma unroll
    for (int j = 0; j < 4; ++j) o8[64 * j] = (unsigned long long)pk2(v[j].x, v[j].y) | ((unsigned long long)pk2(v[j].z, v[j].w) << 32);
}

__device__ __forceinline__ void ph_prep(Frame& F, int l) {
    LAS float* scr = (LAS float*)(F.lds + F.wave * 16384);
    const int gw = F.vcu * NWAVES + F.wave, NGW = F.G * NWAVES, lane = F.lane;
    const float* w_in = F.in[I_WIN] + (size_t)l * D * NIN; const float* gpre = F.in[I_GMIXPRE] + l * D;
    const float* w_so = F.in[I_WSGUOUT] + (size_t)l * D * D; const float* w_co = F.in[I_WCONVOUT] + (size_t)l * D * D; const float* w_po = F.in[I_WPOOLOUT] + (size_t)l * D * D;
    const float* w_out = F.in[I_WOUT] + (size_t)l * D * D; const float* w_f1 = F.in[I_WFFNIN] + (size_t)l * D * 2 * DFF; const float* gf = F.in[I_GFFNPRE] + l * D;
    const float* w_f2 = F.in[I_WFFNOUT] + (size_t)l * DFF * D; const float* w_pg = F.in[I_WPLEGATE] + (size_t)l * D * D; const float* w_ple = F.in[I_WPLE] + (size_t)l * PLED * D;
    const float* w_pool = F.in[I_WPOOL] + (size_t)l * 4 * 256 * 256; const float* s_pool = F.in[I_SPOOL] + l * D;
    bf16* W1A = (bf16*)(F.ws + WS_W1A); bf16* W1B = (bf16*)(F.ws + WS_W1B); bf16* WMIX = (bf16*)(F.ws + WS_WMIX); bf16* WOUT = (bf16*)(F.ws + WS_WOUT);
    bf16* WF1 = (bf16*)(F.ws + WS_WF1); bf16* WF2 = (bf16*)(F.ws + WS_WF2); bf16* WPG = (bf16*)(F.ws + WS_WPG); bf16* WPLE = (bf16*)(F.ws + WS_WPLE); bf16* WPL = (bf16*)(F.ws + WS_WPL);
    constexpr int NI = 2560 + 1536 + 1536 + 512 + 2816 + 1408 + 512 + 128 + 128;
    for (int it = gw; it < NI; it += NGW) {
        int r = it;
        if (r < 2560) { const int kb = r / 160, nb = r % 160, d0 = nb * 32; int sc;
            if (d0 < 2048 || d0 >= 4096) sc = d0; else { const int j = (d0 - 2048) >> 8, rr = (d0 - 2048) & 255; sc = rr < 128 ? 2048 + 128 * j + rr : 3072 + 128 * j + rr - 128; }
            tr_item(w_in, NIN, kb * 64, sc, W1A, D, d0, 0, gpre, nullptr, scr, lane); continue; } r -= 2560;
        if (r < 1536) { const int kb = r / 96, nb = r % 96; tr_item(w_in, NIN, kb * 64, 5120 + nb * 32, W1B, D, nb * 32, 0, gpre, nullptr, scr, lane); continue; } r -= 1536;
        if (r < 1536) { const int s = r / 512, rr = r % 512, kb = rr / 32, nb = rr % 32; const float* src = s == 0 ? w_so : (s == 1 ? w_co : w_po);
            tr_item(src, D, kb * 64, nb * 32, WMIX, 3 * D, nb * 32, s * D, nullptr, nullptr, scr, lane); continue; } r -= 1536;
        if (r < 512) { const int kb = r / 32, nb = r % 32; tr_item(w_out, D, kb * 64, nb * 32, WOUT, D, nb * 32, 0, nullptr, nullptr, scr, lane); continue; } r -= 512;
        if (r < 2816) { const int kb = r / 176, nb = r % 176, d0 = nb * 32, j = d0 >> 8, rr = d0 & 255; const int sc = rr < 128 ? 128 * j + rr : DFF + 128 * j + rr - 128;
            tr_item(w_f1, 2 * DFF, kb * 64, sc, WF1, D, d0, 0, gf, nullptr, scr, lane); continue; } r -= 2816;
        if (r < 1408) { const int kb = r / 32, nb = r % 32; tr_item(w_f2, D, kb * 64, nb * 32, WF2, DFF, nb * 32, 0, nullptr, nullptr, scr, lane); continue; } r -= 1408;
        if (r < 512) { const int kb = r / 32, nb = r % 32; tr_item(w_pg, D, kb * 64, nb * 32, WPG, D, nb * 32, 0, nullptr, nullptr, scr, lane); continue; } r -= 512;
        if (r < 128) { const int kb = r / 32, nb = r % 32; tr_item(w_ple, D, kb * 64, nb * 32, WPLE, PLED, nb * 32, 0, nullptr, nullptr, scr, lane); continue; } r -= 128;
        { const int gidx = r / 32, rr = r % 32, kb = rr / 8, nb = rr % 8; tr_item(w_pool + (size_t)gidx * 65536, 256, kb * 64, nb * 32, WPL, 256, gidx * 256 + nb * 32, 0, nullptr, s_pool, scr, lane); }
    }
    { const float* ws = F.in[I_WSGUS] + (size_t)l * 8 * 128 * 128; bf16* o = (bf16*)(F.ws + WS_WSGU);
      for (int e = F.vcu * 512 + F.tid; e < 8 * 128 * 128; e += F.G * 512) { const int i = (e >> 7) & 127, j = e & 127; float v = ws[e]; if ((j >> 6) > (i >> 6)) v = 0.f; o[e] = (bf16)f2bf(v); } }
    if (l == 0) { bf16* HB = (bf16*)(F.ws + WS_HB0); float* rs = (float*)(F.ws + WS_RS);
        for (int m = gw; m < M; m += NGW) row_to_bf16_rs(F.in[I_X] + (size_t)m * D, HB + (size_t)m * D, rs + m, lane); }
}

__device__ __forceinline__ void conv_unit(Frame& F, int l, int unit, const bf16* HC, bf16* OUT) {
    const int t0 = unit * 8, tpos0 = t0 & (SEQ - 1), c0 = 2 * F.tid;
    const float* wdw = F.in[I_WDW] + (size_t)l * 31 * D;
    f32x2 w[31];
#pragma unroll
    for (int k = 0; k < 31; ++k) w[k] = *(const f32x2*)(wdw + k * D + c0);
    const f32x2 bd = *(const f32x2*)(F.in[I_BDW] + l * D + c0);
    f32x2 acc[8];
#pragma unroll
    for (int o = 0; o < 8; ++o) acc[o] = bd;
#pragma unroll
    for (int r = 0; r < 38; ++r) {
        f32x2 x = {0.f, 0.f};
        if (tpos0 - 30 + r >= 0) { const unsigned v = *(const unsigned*)(HC + (size_t)(t0 - 30 + r) * D + c0); x.x = bflo(v); x.y = bfhi(v); }
#pragma unroll
        for (int o = 0; o < 8; ++o) { const int k = r - o; if (k >= 0 && k <= 30) acc[o] += w[k] * x; }
    }
    LAS float* red = (LAS float*)F.lds;
    float p[16];
#pragma unroll
    for (int o = 0; o < 8; ++o) { p[2 * o] = wave_sum(acc[o].x + acc[o].y); p[2 * o + 1] = wave_sum(acc[o].x * acc[o].x + acc[o].y * acc[o].y); }
    if (F.lane == 0) {
#pragma unroll
        for (int i = 0; i < 16; ++i) red[F.wave * 16 + i] = p[i]; }
    __syncthreads();
    if (F.tid < 16) { float s = 0.f;
#pragma unroll
        for (int w8 = 0; w8 < 8; ++w8) s += red[w8 * 16 + F.tid];
        red[128 + F.tid] = s; }
    __syncthreads();
    const f32x2 gl = *(const f32x2*)(F.in[I_GCONVLN] + l * D + c0), bl = *(const f32x2*)(F.in[I_BCONVLN] + l * D + c0);
#pragma unroll
    for (int o = 0; o < 8; ++o) { const float mu = red[128 + 2 * o] * (1.f / D); const float var = red[128 + 2 * o + 1] * (1.f / D) - mu * mu; const float rstd = 1.0f / sqrtf(fmaxf(var, 0.f) + EPS);
        float y0 = (acc[o].x - mu) * rstd * gl.x + bl.x, y1 = (acc[o].y - mu) * rstd * gl.y + bl.y;
        y0 = y0 * pg8::sigmoidf_fast(y0); y1 = y1 * pg8::sigmoidf_fast(y1);
        *(unsigned*)(OUT + (size_t)(t0 + o) * D + c0) = pk2(y0, y1); }
    __syncthreads();
}
__device__ __forceinline__ void ph_mix1(Frame& F, int l) {
    const bf16* V = (const bf16*)(F.ws + WS_S1); const bf16* HC = (const bf16*)(F.ws + WS_S2); const bf16* ZP = (const bf16*)(F.ws + WS_S3);
    bf16* ACTB = (bf16*)(F.ws + WS_S4); bf16* PO = (bf16*)(F.ws + WS_S5); f32x2* VST = (f32x2*)(F.ws + WS_VST);
    for (int u = F.vcu; u < M / 8; u += F.G) conv_unit(F, l, u, HC, ACTB);
    const int gw = F.vcu * NWAVES + F.wave, NGW = F.G * NWAVES, lane = F.lane;
    for (int m = gw; m < M; m += NGW) {
        {
            const v4u* vr = (const v4u*)(V + (size_t)m * D) + lane; float x[16]; float s = 0.f;
#pragma unroll
            for (int j = 0; j < 2; ++j) { const v4u w = vr[64 * j];
                x[8 * j + 0] = bflo(w.x); x[8 * j + 1] = bfhi(w.x); x[8 * j + 2] = bflo(w.y); x[8 * j + 3] = bfhi(w.y); x[8 * j + 4] = bflo(w.z); x[8 * j + 5] = bfhi(w.z); x[8 * j + 6] = bflo(w.w); x[8 * j + 7] = bfhi(w.w); }
#pragma unroll
            for (int i = 0; i < 16; ++i) s += x[i];
            const float mu = wave_sum(s) * (1.f / D); float q = 0.f;
#pragma unroll
            for (int i = 0; i < 16; ++i) { const float d = x[i] - mu; q += d * d; }
            const float rstd = 1.0f / sqrtf(wave_sum(q) * (1.f / D) + EPS);
            if (lane == 0) VST[m] = (f32x2){mu, rstd};
        }
        {
            const int w = 2 << (lane >> 4), tpos = m & (SEQ - 1); const int cnt = (tpos + 1) < w ? (tpos + 1) : w;
            float s[16], z0[16];
#pragma unroll
            for (int i = 0; i < 16; ++i) s[i] = 0.f;
            for (int j = 0; j < 16; ++j) {
                if (j < cnt) { const v4u* zr = (const v4u*)(ZP + (size_t)(m - j) * D + 16 * lane); const v4u a = zr[0], b = zr[1];
                    float x[16]; x[0] = bflo(a.x); x[1] = bfhi(a.x); x[2] = bflo(a.y); x[3] = bfhi(a.y); x[4] = bflo(a.z); x[5] = bfhi(a.z); x[6] = bflo(a.w); x[7] = bfhi(a.w);
                    x[8] = bflo(b.x); x[9] = bfhi(b.x); x[10] = bflo(b.y); x[11] = bfhi(b.y); x[12] = bflo(b.z); x[13] = bfhi(b.z); x[14] = bflo(b.w); x[15] = bfhi(b.w);
#pragma unroll
                    for (int i = 0; i < 16; ++i) { s[i] += x[i]; if (j == 0) z0[i] = x[i]; } }
            }
            const float inv = 1.0f / (float)cnt; v4u o0, o1;
            o0.x = pk2(s[0] * inv - z0[0], s[1] * inv - z0[1]); o0.y = pk2(s[2] * inv - z0[2], s[3] * inv - z0[3]); o0.z = pk2(s[4] * inv - z0[4], s[5] * inv - z0[5]); o0.w = pk2(s[6] * inv - z0[6], s[7] * inv - z0[7]);
            o1.x = pk2(s[8] * inv - z0[8], s[9] * inv - z0[9]); o1.y = pk2(s[10] * inv - z0[10], s[11] * inv - z0[11]); o1.z = pk2(s[12] * inv - z0[12], s[13] * inv - z0[13]); o1.w = pk2(s[14] * inv - z0[14], s[15] * inv - z0[15]);
            v4u* po = (v4u*)(PO + (size_t)m * D + 16 * lane); po[0] = o0; po[1] = o1;
        }
    }
}
__device__ __forceinline__ void sgu_unit(Frame& F, int l, int unit) {
    const int nb = unit >> 3, h = unit & 7, t0 = nb * 128, c0 = h * 128, tid = F.tid;
    bf16* U = (bf16*)(F.ws + WS_S0); const bf16* V = (const bf16*)(F.ws + WS_S1); const f32x2* VST = (const f32x2*)(F.ws + WS_VST);
    const float* gv = F.in[I_GSGUV] + l * D + c0; const float* bv = F.in[I_BSGUV] + l * D + c0;
    LAS float* vl = (LAS float*)F.lds;
    for (int e = tid; e < 128 * 16; e += 512) { const int j = e >> 4, c8 = (e & 15) * 8; const v4u w = *(const v4u*)(V + (size_t)(t0 + j) * D + c0 + c8); const f32x2 st = VST[t0 + j];
        float x[8]; x[0] = bflo(w.x); x[1] = bfhi(w.x); x[2] = bflo(w.y); x[3] = bfhi(w.y); x[4] = bflo(w.z); x[5] = bfhi(w.z); x[6] = bflo(w.w); x[7] = bfhi(w.w);
#pragma unroll
        for (int k = 0; k < 8; ++k) vl[j * 132 + c8 + k] = (x[k] - st.x) * st.y * gv[c8 + k] + bv[c8 + k]; }
    __syncthreads();
    const int i = tid >> 2, cq = (tid & 3) * 32; const int jmax = i < 64 ? 64 : 128;
    const float* wrow = F.in[I_WSGUS] + ((size_t)(l * 8 + h) * 128 + i) * 128;
    float acc[32];
#pragma unroll
    for (int k = 0; k < 32; ++k) acc[k] = 0.f;
    for (int j = 0; j < jmax; ++j) { const float w = wrow[j]; const LAS f32x4* vp = (const LAS f32x4*)(vl + j * 132 + cq);
#pragma unroll
        for (int k4 = 0; k4 < 8; ++k4) { const f32x4 x = vp[k4]; acc[4 * k4 + 0] += w * x.x; acc[4 * k4 + 1] += w * x.y; acc[4 * k4 + 2] += w * x.z; acc[4 * k4 + 3] += w * x.w; } }
    const float bias = F.in[I_BSGUS][(l * 8 + h) * 128 + i];
    v4u* up = (v4u*)(U + (size_t)(t0 + i) * D + c0 + cq);
#pragma unroll
    for (int k8 = 0; k8 < 4; ++k8) { const v4u w = up[k8]; v4u o;
        o.x = pk2(bflo(w.x) * (acc[8 * k8 + 0] + bias), bfhi(w.x) * (acc[8 * k8 + 1] + bias)); o.y = pk2(bflo(w.y) * (acc[8 * k8 + 2] + bias), bfhi(w.y) * (acc[8 * k8 + 3] + bias));
        o.z = pk2(bflo(w.z) * (acc[8 * k8 + 4] + bias), bfhi(w.z) * (acc[8 * k8 + 5] + bias)); o.w = pk2(bflo(w.w) * (acc[8 * k8 + 6] + bias), bfhi(w.w) * (acc[8 * k8 + 7] + bias));
        up[k8] = o; }
    __syncthreads();
}
__device__ __forceinline__ void ph_rows_norm(Frame& F, const float* Y, const float* base, const float* gain, bf16* HB, float* rs_out) {
    const int gw = F.vcu * NWAVES + F.wave, NGW = F.G * NWAVES, lane = F.lane;
    for (int m = gw; m < M; m += NGW) {
        const f32x4* yr = (const f32x4*)(Y + (size_t)m * D) + lane; const f32x4* br = (const f32x4*)(base + (size_t)m * D) + lane; const f32x4* gr = (const f32x4*)gain + lane;
        f32x4 y[4]; float s = 0.f;
#pragma unroll
        for (int j = 0; j < 4; ++j) { y[j] = yr[64 * j]; s += (y[j].x * y[j].x + y[j].y * y[j].y) + (y[j].z * y[j].z + y[j].w * y[j].w); }
        const float rstd = 1.0f / sqrtf(wave_sum(s) * (1.f / D) + EPS); float s2 = 0.f;
        f32x4* orow = (f32x4*)(F.out + (size_t)m * D) + lane; unsigned long long* o8 = (unsigned long long*)(HB + (size_t)m * D) + lane;
#pragma unroll
        for (int j = 0; j < 4; ++j) { const f32x4 hn = br[64 * j] + y[j] * rstd * gr[64 * j]; orow[64 * j] = hn; s2 += (hn.x * hn.x + hn.y * hn.y) + (hn.z * hn.z + hn.w * hn.w);
            o8[64 * j] = (unsigned long long)pk2(hn.x, hn.y) | ((unsigned long long)pk2(hn.z, hn.w) << 32); }
        if (rs_out) { s2 = wave_sum(s2); if (lane == 0) rs_out[m] = 1.0f / sqrtf(s2 * (1.f / D) + EPS); }
    }
}

enum { PH_PREP = 0, PH_G1A, PH_MIX1, PH_MIX2, PH_G1B, PH_MERGE, PH_WOUT, PH_ROWS1, PH_FFN1, PH_FFN2, PH_ROWS2, PH_PLEQ, PH_PLE, PH_ROWS3, NPH };
constexpr int N_PHASES = DEPTH * NPH - 1;
struct Args { const float* in[N_IN]; float* out; unsigned char* ws; int ph_lo, ph_hi; };
static_assert(sizeof(Args) == N_IN * 8 + 24, "Args has no padding");

__global__ void __launch_bounds__(NWAVES * 64, 2) mega(Args args) {
    extern __shared__ __attribute__((aligned(16))) unsigned char lds_raw[];
    Frame F;
    F.lds = (LAS unsigned char*)lds_raw;
    F.MISC = (volatile LAS unsigned*)(F.lds + MISC_OFF);
    F.tid = threadIdx.x; F.lane = F.tid & 63; F.wave = __builtin_amdgcn_readfirstlane(F.tid >> 6);
    F.G = gridDim.x; { const int bx = blockIdx.x; F.vcu = (F.G % 8 == 0) ? (bx % 8) * (F.G / 8) + bx / 8 : bx; }
    F.ws = args.ws; F.out = args.out; F.ctl = (gu32*)(args.ws + WS_CTL);
#pragma unroll
    for (int i = 0; i < N_IN; ++i) F.in[i] = args.in[i];
    for (int u = F.tid; u < (LDS_BYTES - LDSCTL_OFF) / 4; u += NWAVES * 64) ((LAS unsigned*)(F.lds + LDSCTL_OFF))[u] = 0u;
    __syncthreads();
    XcdBarrier bar; bar.bar = (unsigned*)(F.ctl + CW_BAR); bar.x = 0; bar.st = nullptr;
    const bool multi = (args.ph_hi - args.ph_lo) > 1;
    if (multi) bar = xcd_barrier_post((unsigned*)(F.ctl + CW_BAR), F.MISC + 8);

    unsigned char* ws = F.ws;
    const size_t TS = (size_t)M * D;

    for (int ph = args.ph_lo; ph < args.ph_hi; ++ph) {
        { int t_ = threadIdx.x; asm volatile("" : "+v"(t_)); F.tid = t_; F.lane = t_ & 63; F.wave = __builtin_amdgcn_readfirstlane(t_ >> 6);
          unsigned long long w_ = (unsigned long long)args.ws; asm volatile("" : "+s"(w_)); ws = (unsigned char*)(GAS unsigned char*)w_; F.ws = ws; }
        bf16* HB0 = (bf16*)(ws + WS_HB0); bf16* S0 = (bf16*)(ws + WS_S0); bf16* S1 = (bf16*)(ws + WS_S1); bf16* S2 = (bf16*)(ws + WS_S2); bf16* S3 = (bf16*)(ws + WS_S3);
        bf16* S4 = (bf16*)(ws + WS_S4); bf16* S5 = (bf16*)(ws + WS_S5);
        float* RS = (float*)(ws + WS_RS); float* RS2 = (float*)(ws + WS_RS2);
        const int l = ph / NPH, k = ph % NPH;
        if (k == PH_PREP) ph_prep(F, l);
        if (k == PH_G1A) {
            pg8::Gemm g{HB0, nullptr, nullptr, (const bf16*)(ws + WS_W1A), D, D, M, 5120, D, 0}; pg8::StaticOrder S; S.init(M, 5120, F.G, (int)blockIdx.x);
            pg8::EpiG1a E{S0, S1, S2, S3, RS};
            pg8::gemm_phase<pg8::EpiG1a, true, false>(F.lds, g, S, E, F.tid);
        }
        if (k == PH_MIX1) ph_mix1(F, l);
        if (k == PH_MIX2) { for (int u = F.vcu; u < 1024; u += F.G) sgu_unit(F, l, u); }
        if (k == PH_MIX2 || k == PH_PLEQ) {
            pg8::Gemm g; pg8::EpiBf16 E;
            if (k == PH_MIX2) { g = pg8::Gemm{S5, nullptr, nullptr, (const bf16*)(ws + WS_WPL), D, 256, M, D, 256, 256}; E = pg8::EpiBf16{S5, D}; }
            else { g = pg8::Gemm{S0, nullptr, nullptr, (const bf16*)(ws + WS_WPLE), PLED, PLED, M, D, PLED, 0}; E = pg8::EpiBf16{S1, D}; }
            pg8::StaticOrder S; S.init(M, D, F.G, (int)blockIdx.x);
            pg8::gemm_phase<pg8::EpiBf16, false, false>(F.lds, g, S, E, F.tid);
        }
        if (k == PH_G1B) {
            pg8::Gemm g{HB0, nullptr, nullptr, (const bf16*)(ws + WS_W1B), D, D, M, 3072, D, 0}; pg8::StaticOrder S; S.init(M, 3072, F.G, (int)blockIdx.x);
            pg8::EpiGate E{S1, RS, TS};
            pg8::gemm_phase<pg8::EpiGate, true, false>(F.lds, g, S, E, F.tid);
        }
        if (k == PH_MERGE) {
            pg8::Gemm g{S0, S4, S5, (const bf16*)(ws + WS_WMIX), D, 3 * D, M, D, 3 * D, 0}; pg8::StaticOrder S; S.init(M, D, F.G, (int)blockIdx.x);
            pg8::EpiMerged E{HB0, S1, TS};
            pg8::gemm_phase<pg8::EpiMerged, false, true>(F.lds, g, S, E, F.tid);
        }
        if (k == PH_WOUT || k == PH_FFN2) {
            pg8::Gemm g; pg8::EpiF32 E;
            if (k == PH_WOUT) { g = pg8::Gemm{HB0, nullptr, nullptr, (const bf16*)(ws + WS_WOUT), D, D, M, D, D, 0}; E = pg8::EpiF32{(float*)S1, D}; }
            else { g = pg8::Gemm{S1, nullptr, nullptr, (const bf16*)(ws + WS_WF2), DFF, DFF, M, D, DFF, 0}; E = pg8::EpiF32{(float*)S4, D}; }
            pg8::StaticOrder S; S.init(M, D, F.G, (int)blockIdx.x);
            pg8::gemm_phase<pg8::EpiF32, false, false>(F.lds, g, S, E, F.tid);
        }
        if (k == PH_ROWS1) ph_rows_norm(F, (const float*)S1, l == 0 ? F.in[I_X] : F.out, F.in[I_GMIXPOST] + l * D, S0, RS2);
        if (k == PH_FFN1) {
            pg8::Gemm g{S0, nullptr, nullptr, (const bf16*)(ws + WS_WF1), D, D, M, 2 * DFF, D, 0}; pg8::StaticOrder S; S.init(M, 2 * DFF, F.G, (int)blockIdx.x);
            pg8::EpiSwiGLU E{S1, DFF, RS2};
            pg8::gemm_phase<pg8::EpiSwiGLU, true, false>(F.lds, g, S, E, F.tid);
        }
        if (k == PH_ROWS2) {
            ph_rows_norm(F, (const float*)S4, F.out, F.in[I_GFFNPOST] + l * D, HB0, nullptr);
            const f32x4* pp = (const f32x4*)(F.in[I_P] + (size_t)l * M * PLED); v2u* po = (v2u*)S0;
            for (int e = F.vcu * 512 + F.tid; e < M * PLED / 4; e += F.G * 512) { const f32x4 v = pp[e]; v2u o; o.x = pk2(v.x, v.y); o.y = pk2(v.z, v.w); po[e] = o; }
        }
        if (k == PH_PLE) {
            pg8::Gemm g{HB0, nullptr, nullptr, (const bf16*)(ws + WS_WPG), D, D, M, D, D, 0}; pg8::StaticOrder S; S.init(M, D, F.G, (int)blockIdx.x);
            pg8::EpiPle E{F.out, S1};
            pg8::gemm_phase<pg8::EpiPle, false, false>(F.lds, g, S, E, F.tid);
        }
        if (k == PH_ROWS3) { const int gw = F.vcu * NWAVES + F.wave, NGW = F.G * NWAVES;
            for (int m = gw; m < M; m += NGW) row_to_bf16_rs(F.out + (size_t)m * D, HB0 + (size_t)m * D, RS + m, F.lane); }
        if (ph + 1 < args.ph_hi) xcd_barrier(bar);
    }
}

extern "C" void kernel_launch(void* const* d_in, const int* in_sizes, int n_in, void* d_out, int out_size, void* d_ws, size_t ws_size, hipStream_t stream) {
    static int grid = 0;
    if (grid == 0) {
        if (n_in != N_IN || in_sizes[0] != M * D || out_size != M * D || ws_size < WS_END) { fprintf(stderr, "kernel_launch: unexpected shapes (n_in %d, in0 %d, out %d, ws %zu < %zu)\n", n_in, n_in > 0 ? in_sizes[0] : -1, out_size, ws_size, (size_t)WS_END); grid = -1; return; }
        int dev = 0, cus = 0, per_cu = 0;
        if (hipGetDevice(&dev) != hipSuccess || hipDeviceGetAttribute(&cus, hipDeviceAttributeMultiprocessorCount, dev) != hipSuccess) { grid = -1; return; }
        if (hipFuncSetAttribute((const void*)mega, hipFuncAttributeMaxDynamicSharedMemorySize, LDS_BYTES) != hipSuccess) { fprintf(stderr, "kernel_launch: hipFuncSetAttribute failed\n"); grid = -1; return; }
        if (hipOccupancyMaxActiveBlocksPerMultiprocessor(&per_cu, (const void*)mega, NWAVES * 64, LDS_BYTES) != hipSuccess || per_cu < 1) { fprintf(stderr, "kernel_launch: occupancy query says %d blocks per CU\n", per_cu); }
        (void)hipGetLastError();
        grid = cus;
    }
    if (grid < 0) return;
    if (hipMemsetAsync((char*)d_ws + WS_CTL, 0, CTL_ZERO_BYTES, stream) != hipSuccess) return;
    Args a{};
    for (int i = 0; i < N_IN; ++i) a.in[i] = (const float*)d_in[i];
    a.out = (float*)d_out; a.ws = (unsigned char*)d_ws;
#if MK_ONE_LAUNCH
    a.ph_lo = 0; a.ph_hi = N_PHASES;
    hipLaunchKernelGGL(mega, dim3(grid), dim3(NWAVES * 64), LDS_BYTES, stream, a);
#else
    for (int ph = 0; ph < N_PHASES; ++ph) { a.ph_lo = ph; a.ph_hi = ph + 1; hipLaunchKernelGGL(mega, dim3(grid), dim3(NWAVES * 64), LDS_BYTES, stream, a); }
#endif
}
```

```cpp
#include <hip/hip_runtime.h>
#include <cstdio>
#include <cstdint>

#ifndef MK_ONE_LAUNCH
#define MK_ONE_LAUNCH 1
#endif

namespace pg8 {
#define PG8_LAS __attribute__((address_space(3)))
typedef unsigned short bf16_t;
typedef short bf16x8 __attribute__((ext_vector_type(8)));
typedef float f32x4 __attribute__((ext_vector_type(4)));
typedef unsigned u32x4 __attribute__((ext_vector_type(4)));
constexpr int BM = 256, BK = 64, HALF = 128, HTB = HALF * BK * 2, STAGE_BYTES = 8 * HTB, NXCD = 8, WGM = 8;

__host__ __device__ __forceinline__ int lds_byte(int r, int c) { const int st = (r >> 4) * 2 + (c >> 5), rr = r & 15, cc = c & 31, ob = rr * 64 + cc * 2; return st * 1024 + (ob ^ (((ob >> 9) & 1) << 5)); }
__host__ __device__ __forceinline__ void stage_rc(int b, int& R, int& C) { const int st = b / 1024, sb = b % 1024, swz = sb ^ (((sb >> 9) & 1) << 5); R = (st >> 1) * 16 + swz / 64; C = (st & 1) * 32 + (swz % 64) / 2; }
__host__ __device__ __forceinline__ int perm32(int rho) { const int n = rho >> 4, i = rho & 15; return 8 * (i >> 2) + 4 * n + (i & 3); }

struct Unit { int pm, pn; };
struct Gemm { const bf16_t* A0; const bf16_t* A1; const bf16_t* A2; const bf16_t* Bt; int lda, ldb, M, N, K, a_pn_off; };

struct StaticOrder {
    int nM, nN, nwg, G, c;
    __host__ __device__ void init(int M, int N, int G_, int c_) { nM = M / BM; nN = N / BM; nwg = nM * nN; G = G_; c = c_; }
    __host__ __device__ bool next(int i, Unit& u) const {
        const long L = (long)i * G + c; if (L >= nwg) return false;
        int wgid = (int)L; { const int q = nwg / NXCD, r = nwg % NXCD, xcd = wgid % NXCD, off = wgid / NXCD; wgid = (xcd < r ? xcd * (q + 1) : r * (q + 1) + (xcd - r) * q) + off; }
        const int nig = WGM * nN, gid = wgid / nig, fm = gid * WGM, gsz = (nM - fm) < WGM ? (nM - fm) : WGM;
        u.pm = fm + ((wgid % nig) % gsz); u.pn = (wgid % nig) / gsz; return true;
    }
};

__device__ __forceinline__ unsigned cvt_pk_bf16(float lo, float hi) { unsigned r; asm volatile("v_cvt_pk_bf16_f32 %0, %1, %2" : "=v"(r) : "v"(lo), "v"(hi)); return r; }
__device__ __forceinline__ u32x4 pack8(const f32x4& a, const f32x4& b) { u32x4 w; w.x = cvt_pk_bf16(a[0], a[1]); w.y = cvt_pk_bf16(a[2], a[3]); w.z = cvt_pk_bf16(b[0], b[1]); w.w = cvt_pk_bf16(b[2], b[3]); return w; }
__device__ __forceinline__ void unpack8(const u32x4& w, f32x4& a, f32x4& b) {
    a[0] = __uint_as_float(w.x << 16); a[1] = __uint_as_float(w.x & 0xffff0000u); a[2] = __uint_as_float(w.y << 16); a[3] = __uint_as_float(w.y & 0xffff0000u);
    b[0] = __uint_as_float(w.z << 16); b[1] = __uint_as_float(w.z & 0xffff0000u); b[2] = __uint_as_float(w.w << 16); b[3] = __uint_as_float(w.w & 0xffff0000u); }
__device__ __forceinline__ float sigmoidf_fast(float x) { return __builtin_amdgcn_rcpf(1.0f + __builtin_amdgcn_exp2f(-1.4426950409f * x)); }
__device__ __forceinline__ float gelu_tanh(float x) { return x * sigmoidf_fast(1.5957691216f * x * (1.0f + 0.044715f * x * x)); }
__device__ __forceinline__ f32x4 sig4(f32x4 v) { f32x4 o; o[0] = sigmoidf_fast(v[0]); o[1] = sigmoidf_fast(v[1]); o[2] = sigmoidf_fast(v[2]); o[3] = sigmoidf_fast(v[3]); return o; }
__device__ __forceinline__ f32x4 gelu4(f32x4 v) { f32x4 o; o[0] = gelu_tanh(v[0]); o[1] = gelu_tanh(v[1]); o[2] = gelu_tanh(v[2]); o[3] = gelu_tanh(v[3]); return o; }

typedef f32x4 Acc[2][2][4][2];

struct EpiG1a {
    static constexpr bool PERM = true, AFTER_DRAIN = false;
    bf16_t *U, *V, *HC, *ZP; const float* rs; float* vstp;
    __device__ __forceinline__ void mid(Acc&, const Unit&, int, int, int, int, int) const {}
    __device__ __forceinline__ void operator()(const Acc& acc, const Unit& u, int wr, int wc, int fr, int fq) const {
        const int row0 = u.pm * BM + wr * 64 + fr, pn = u.pn;
        if (pn < 8) {
            bf16_t* base = (pn < 4 ? U : V) + (pn & 3) * 256 + wc * 32 + 8 * fq;
#pragma unroll
            for (int ai = 0; ai < 2; ++ai)
#pragma unroll
                for (int m = 0; m < 4; ++m) { const int row = row0 + ai * HALF + m * 16; const float r = rs[row]; bf16_t* rowp = base + (size_t)row * 1024;
                    float s1 = 0.f, s2 = 0.f;
#pragma unroll
                    for (int bj = 0; bj < 2; ++bj) { const f32x4 v0 = gelu4(acc[ai][bj][m][0] * r), v1 = gelu4(acc[ai][bj][m][1] * r); *(u32x4*)(rowp + bj * HALF) = pack8(v0, v1);
                        s1 += ((v0[0] + v0[1]) + (v0[2] + v0[3])) + ((v1[0] + v1[1]) + (v1[2] + v1[3]));
                        s2 += ((v0[0] * v0[0] + v0[1] * v0[1]) + (v0[2] * v0[2] + v0[3] * v0[3])) + ((v1[0] * v1[0] + v1[1] * v1[1]) + (v1[2] * v1[2] + v1[3] * v1[3])); }
                    if (pn >= 4) { s1 += __shfl_xor(s1, 16); s1 += __shfl_xor(s1, 32); s2 += __shfl_xor(s2, 16); s2 += __shfl_xor(s2, 32);
                        if (fq == 0) { float* q = vstp + ((size_t)row * 16 + (pn - 4) * 4 + wc) * 2; q[0] = s1; q[1] = s2; } } }
        } else if (pn < 16) {
            bf16_t* base = HC + (pn - 8) * 128 + wc * 32 + 8 * fq;
#pragma unroll
            for (int ai = 0; ai < 2; ++ai)
#pragma unroll
                for (int m = 0; m < 4; ++m) { const int row = row0 + ai * HALF + m * 16; const float r = rs[row]; bf16_t* rowp = base + (size_t)row * 1024;
                    const f32x4 v0 = (acc[ai][0][m][0] * r) * sig4(acc[ai][1][m][0] * r), v1 = (acc[ai][0][m][1] * r) * sig4(acc[ai][1][m][1] * r);
                    *(u32x4*)(rowp) = pack8(v0, v1); }
        } else {
            bf16_t* base = ZP + (pn - 16) * 256 + wc * 32 + 8 * fq;
#pragma unroll
            for (int ai = 0; ai < 2; ++ai)
#pragma unroll
                for (int m = 0; m < 4; ++m) { const int row = row0 + ai * HALF + m * 16; const float r = rs[row]; bf16_t* rowp = base + (size_t)row * 1024;
#pragma unroll
                    for (int bj = 0; bj < 2; ++bj) { const f32x4 v0 = acc[ai][bj][m][0] * r, v1 = acc[ai][bj][m][1] * r; *(u32x4*)(rowp + bj * HALF) = pack8(v0, v1); } }
        }
    }
};
struct EpiGate {
    static constexpr bool PERM = true, AFTER_DRAIN = false;
    bf16_t* G; const float* rs; size_t tstride;
    __device__ __forceinline__ void mid(Acc&, const Unit&, int, int, int, int, int) const {}
    __device__ __forceinline__ void operator()(const Acc& acc, const Unit& u, int wr, int wc, int fr, int fq) const {
        const int row0 = u.pm * BM + wr * 64 + fr;
        bf16_t* base = G + (size_t)(u.pn >> 2) * tstride + (u.pn & 3) * 256 + wc * 32 + 8 * fq;
#pragma unroll
        for (int ai = 0; ai < 2; ++ai)
#pragma unroll
            for (int m = 0; m < 4; ++m) { const int row = row0 + ai * HALF + m * 16; const float r = rs[row]; bf16_t* rowp = base + (size_t)row * 1024;
#pragma unroll
                for (int bj = 0; bj < 2; ++bj) { const f32x4 v0 = sig4(acc[ai][bj][m][0] * r), v1 = sig4(acc[ai][bj][m][1] * r); *(u32x4*)(rowp + bj * HALF) = pack8(v0, v1); } }
    }
};
struct EpiBf16 {
    static constexpr bool PERM = true, AFTER_DRAIN = false;
    bf16_t* O; int ldc;
    __device__ __forceinline__ void mid(Acc&, const Unit&, int, int, int, int, int) const {}
    __device__ __forceinline__ void operator()(const Acc& acc, const Unit& u, int wr, int wc, int fr, int fq) const {
        const int row0 = u.pm * BM + wr * 64 + fr;
        bf16_t* base = O + u.pn * 256 + wc * 32 + 8 * fq;
#pragma unroll
        for (int ai = 0; ai < 2; ++ai)
#pragma unroll
            for (int m = 0; m < 4; ++m) { bf16_t* rowp = base + (size_t)(row0 + ai * HALF + m * 16) * ldc;
#pragma unroll
                for (int bj = 0; bj < 2; ++bj) *(u32x4*)(rowp + bj * HALF) = pack8(acc[ai][bj][m][0], acc[ai][bj][m][1]); }
    }
};
struct EpiF32 {
    static constexpr bool PERM = true, AFTER_DRAIN = false;
    float* Y; int ldc;
    __device__ __forceinline__ void mid(Acc&, const Unit&, int, int, int, int, int) const {}
    __device__ __forceinline__ void operator()(const Acc& acc, const Unit& u, int wr, int wc, int fr, int fq) const {
        const int row0 = u.pm * BM + wr * 64 + fr;
        float* base = Y + u.pn * 256 + wc * 32 + 8 * fq;
#pragma unroll
        for (int ai = 0; ai < 2; ++ai)
#pragma unroll
            for (int m = 0; m < 4; ++m) { float* rowp = base + (size_t)(row0 + ai * HALF + m * 16) * ldc;
#pragma unroll
                for (int bj = 0; bj < 2; ++bj) { *(f32x4*)(rowp + bj * HALF) = acc[ai][bj][m][0]; *(f32x4*)(rowp + bj * HALF + 4) = acc[ai][bj][m][1]; } }
    }
};
struct EpiSwiGLU {
    static constexpr bool PERM = true, AFTER_DRAIN = false;
    bf16_t* Fo; int ldc; const float* rs;
    __device__ __forceinline__ void mid(Acc&, const Unit&, int, int, int, int, int) const {}
    __device__ __forceinline__ void operator()(const Acc& acc, const Unit& u, int wr, int wc, int fr, int fq) const {
        const int row0 = u.pm * BM + wr * 64 + fr;
        bf16_t* base = Fo + u.pn * 128 + wc * 32 + 8 * fq;
#pragma unroll
        for (int ai = 0; ai < 2; ++ai)
#pragma unroll
            for (int m = 0; m < 4; ++m) { const int row = row0 + ai * HALF + m * 16; const float r = rs[row]; bf16_t* rowp = base + (size_t)row * ldc;
                const f32x4 g0 = acc[ai][0][m][0] * r, g1 = acc[ai][0][m][1] * r;
                const f32x4 v0 = g0 * sig4(g0) * (acc[ai][1][m][0] * r), v1 = g1 * sig4(g1) * (acc[ai][1][m][1] * r);
                *(u32x4*)(rowp) = pack8(v0, v1); }
    }
};
struct EpiMerged {
    static constexpr bool PERM = true, AFTER_DRAIN = false;
    bf16_t* O; const bf16_t* G; size_t tstride;
    __device__ __forceinline__ void mid(Acc& acc, const Unit& u, int seg, int wr, int wc, int fr, int fq) const {
        const int row0 = u.pm * BM + wr * 64 + fr;
        const bf16_t* gp = G + (size_t)(seg - 1) * tstride + u.pn * 256 + wc * 32 + 8 * fq; const bf16_t* gc = gp + tstride;
#pragma unroll
        for (int ai = 0; ai < 2; ++ai)
#pragma unroll
            for (int m = 0; m < 4; ++m) { const size_t ro = (size_t)(row0 + ai * HALF + m * 16) * 1024;
#pragma unroll
                for (int bj = 0; bj < 2; ++bj) { const u32x4 wp = *(const u32x4*)(gp + ro + bj * HALF), wq = *(const u32x4*)(gc + ro + bj * HALF);
                    f32x4 p0, p1, c0, c1; unpack8(wp, p0, p1); unpack8(wq, c0, c1);
#pragma unroll
                    for (int j = 0; j < 4; ++j) { acc[ai][bj][m][0][j] *= p0[j] * __builtin_amdgcn_rcpf(c0[j]); acc[ai][bj][m][1][j] *= p1[j] * __builtin_amdgcn_rcpf(c1[j]); } } }
    }
    __device__ __forceinline__ void operator()(const Acc& acc, const Unit& u, int wr, int wc, int fr, int fq) const {
        const int row0 = u.pm * BM + wr * 64 + fr;
        const bf16_t* g2 = G + 2 * tstride + u.pn * 256 + wc * 32 + 8 * fq;
        bf16_t* base = O + u.pn * 256 + wc * 32 + 8 * fq;
#pragma unroll
        for (int ai = 0; ai < 2; ++ai)
#pragma unroll
            for (int m = 0; m < 4; ++m) { const size_t ro = (size_t)(row0 + ai * HALF + m * 16) * 1024;
#pragma unroll
                for (int bj = 0; bj < 2; ++bj) { const u32x4 wg = *(const u32x4*)(g2 + ro + bj * HALF); f32x4 a, b; unpack8(wg, a, b);
                    *(u32x4*)(base + ro + bj * HALF) = pack8(acc[ai][bj][m][0] * a, acc[ai][bj][m][1] * b); } }
    }
};
struct EpiPle {
    static constexpr bool PERM = true, AFTER_DRAIN = false;
    float* H; const bf16_t* Q;
    __device__ __forceinline__ void mid(Acc&, const Unit&, int, int, int, int, int) const {}
    __device__ __forceinline__ void operator()(const Acc& acc, const Unit& u, int wr, int wc, int fr, int fq) const {
        const int row0 = u.pm * BM + wr * 64 + fr; const int col0 = u.pn * 256 + wc * 32 + 8 * fq;
#pragma unroll
        for (int ai = 0; ai < 2; ++ai)
#pragma unroll
            for (int m = 0; m < 4; ++m) { const size_t ro = (size_t)(row0 + ai * HALF + m * 16) * 1024 + col0;
#pragma unroll
                for (int bj = 0; bj < 2; ++bj) { const u32x4 wq = *(const u32x4*)(Q + ro + bj * HALF); f32x4 q0, q1; unpack8(wq, q0, q1);
                    float* hp = H + ro + bj * HALF; const f32x4 h0 = *(const f32x4*)hp, h1 = *(const f32x4*)(hp + 4);
                    *(f32x4*)hp = h0 + sig4(acc[ai][bj][m][0]) * q0; *(f32x4*)(hp + 4) = h1 + sig4(acc[ai][bj][m][1]) * q1; } }
    }
};

__device__ __forceinline__ const char* a_addr(const Gemm& g, bool seg3, int pm, int pn, int t, size_t tstepA) {
    if (seg3) { const bf16_t* b = t < 16 ? g.A0 : (t < 32 ? g.A1 : g.A2); return (const char*)b + (size_t)pm * tstepA + (size_t)(t & 15) * (BK * 2); }
    return (const char*)g.A0 + (size_t)pm * tstepA + (size_t)pn * g.a_pn_off * 2 + (size_t)t * (BK * 2);
}

template <class Epi, bool ALIGN_EPI, bool SEG3>
__device__ __forceinline__ void gemm_phase(PG8_LAS unsigned char* lds, const Gemm g, const StaticOrder& S, const Epi& E, const int tid) {
    const int wid = __builtin_amdgcn_readfirstlane(tid >> 6), lane = tid & 63, wr = wid >> 2, wc = wid & 3, fr = lane & 15, fq = lane >> 4;
    const int K = g.K, nt = K / BK;
    unsigned voffA[2], voffB[2];
#pragma unroll
    for (int i = 0; i < 2; ++i) { int R, C; stage_rc(tid * 16 + i * 8192, R, C); const int Rb = Epi::PERM ? ((R & ~31) + perm32(R & 31)) : R;
        voffA[i] = (unsigned)(R * g.lda + C) * 2u; voffB[i] = (unsigned)(Rb * g.ldb + C) * 2u; }
    const size_t kstep = (size_t)(BK * 2);
    const size_t hstepA = (size_t)HALF * g.lda * 2, hstepB = (size_t)HALF * g.ldb * 2;
    const size_t tstepA = 2 * hstepA, tstepB = 2 * hstepB;
    const unsigned ldsw = (unsigned)wid * 1024u;
    const int aoff = lds_byte(wr * 64 + fr, fq * 8), boff = lds_byte(wc * 32 + fr, fq * 8);
#define PG8_SA(b, h) (((b) * 2 + (h)) * HTB)
#define PG8_SB(b, h) ((4 + (b) * 2 + (h)) * HTB)
#define PG8_STAGE(bufoff, gbase, voff) do { _Pragma("unroll") for (int _i = 0; _i < 2; ++_i) \
        __builtin_amdgcn_global_load_lds((const unsigned*)((const char*)(gbase) + (voff)[_i]), (PG8_LAS unsigned*)(lds + (bufoff) + ldsw + _i * 8192), 16, 0, 0); } while (0)
#define PG8_LDA(dst, b, h) do { _Pragma("unroll") for (int m = 0; m < 4; ++m) _Pragma("unroll") for (int k = 0; k < 2; ++k) dst[m][k] = *(const PG8_LAS bf16x8*)(lds + PG8_SA(b, h) + aoff + m * 2048 + k * 1024); } while (0)
#define PG8_LDB(dst, b, h) do { _Pragma("unroll") for (int n = 0; n < 2; ++n) _Pragma("unroll") for (int k = 0; k < 2; ++k) dst[n][k] = *(const PG8_LAS bf16x8*)(lds + PG8_SB(b, h) + boff + n * 2048 + k * 1024); } while (0)
#define PG8_MMA(ai, bj, At, Bt) do { __builtin_amdgcn_s_setprio(1); _Pragma("unroll") for (int m = 0; m < 4; ++m) _Pragma("unroll") for (int n = 0; n < 2; ++n) _Pragma("unroll") for (int k = 0; k < 2; ++k) \
        acc[ai][bj][m][n] = __builtin_amdgcn_mfma_f32_16x16x32_bf16(Bt[n][k], At[m][k], acc[ai][bj][m][n], 0, 0, 0); __builtin_amdgcn_s_setprio(0); } while (0)
#define PG8_WAIT_V(n) asm volatile("s_waitcnt vmcnt(" #n ")" ::: "memory")
#define PG8_WAIT_L(n) asm volatile("s_waitcnt lgkmcnt(" #n ")" ::: "memory")
#define PG8_BAR __builtin_amdgcn_s_barrier()
#define PG8_SCHED __builtin_amdgcn_sched_barrier(0)
    Unit cur, nxt; int ui = 0;
    if (!S.next(0, cur)) return;
    Acc acc;
#pragma unroll
    for (int a = 0; a < 2; ++a)
#pragma unroll
        for (int b = 0; b < 2; ++b)
#pragma unroll
            for (int m = 0; m < 4; ++m)
#pragma unroll
                for (int n = 0; n < 2; ++n) acc[a][b][m][n] = (f32x4){0.f, 0.f, 0.f, 0.f};
    bf16x8 At[4][2], B0[2][2], B1[2][2];
    const char* cB = (const char*)g.Bt + (size_t)cur.pn * tstepB;
    {
        const char* cA0 = a_addr(g, SEG3, cur.pm, cur.pn, 0, tstepA); const char* cA1 = a_addr(g, SEG3, cur.pm, cur.pn, 1, tstepA);
        PG8_STAGE(PG8_SB(0, 0), cB, voffB); PG8_STAGE(PG8_SB(0, 1), cB + hstepB, voffB); PG8_STAGE(PG8_SA(0, 0), cA0, voffA); PG8_STAGE(PG8_SA(0, 1), cA0 + hstepA, voffA);
        if (wr == 1) PG8_BAR;
        PG8_WAIT_V(2); PG8_BAR;
        PG8_STAGE(PG8_SB(1, 0), cB + kstep, voffB); PG8_STAGE(PG8_SA(1, 0), cA1, voffA); PG8_STAGE(PG8_SB(1, 1), cB + hstepB + kstep, voffB);
        PG8_WAIT_V(6); PG8_BAR;
    }
    for (;;) {
        const bool has_next = S.next(ui + 1, nxt);
        const Unit nu = has_next ? nxt : cur;
        const char* nB = (const char*)g.Bt + (size_t)nu.pn * tstepB;
        for (int t = 0; t < nt; t += 2) {
            const bool last = (t == nt - 2);
            if (SEG3 && (t == 16 || t == 32)) E.mid(acc, cur, t >> 4, wr, wc, fr, fq);
            const char* a1 = a_addr(g, SEG3, cur.pm, cur.pn, t + 1, tstepA);
            const char* a2 = last ? a_addr(g, SEG3, nu.pm, nu.pn, 0, tstepA) : a_addr(g, SEG3, cur.pm, cur.pn, t + 2, tstepA);
            const char* a3 = last ? a_addr(g, SEG3, nu.pm, nu.pn, 1, tstepA) : a_addr(g, SEG3, cur.pm, cur.pn, t + 3, tstepA);
            const char* b2 = last ? nB : cB + (size_t)(t + 2) * kstep; const char* b3 = b2 + kstep;
            PG8_LDB(B0, 0, 0); PG8_LDB(B1, 0, 1); PG8_SCHED; PG8_LDA(At, 0, 0); PG8_STAGE(PG8_SA(1, 1), a1 + hstepA, voffA);
            PG8_WAIT_V(8); PG8_WAIT_L(0); PG8_BAR; PG8_MMA(0, 0, At, B0); PG8_MMA(0, 1, At, B1); PG8_BAR; PG8_SCHED;
            PG8_LDA(At, 0, 1); PG8_STAGE(PG8_SB(0, 0), b2, voffB); PG8_STAGE(PG8_SB(0, 1), b2 + hstepB, voffB); PG8_STAGE(PG8_SA(0, 0), a2, voffA);
            PG8_WAIT_V(8); PG8_WAIT_L(0); PG8_BAR; PG8_MMA(1, 0, At, B0); PG8_MMA(1, 1, At, B1); PG8_BAR; PG8_SCHED;
            PG8_LDB(B0, 1, 0); PG8_LDB(B1, 1, 1); PG8_SCHED; PG8_LDA(At, 1, 0); PG8_STAGE(PG8_SA(0, 1), a2 + hstepA, voffA);
            PG8_WAIT_V(8); PG8_WAIT_L(0); PG8_BAR; PG8_MMA(0, 0, At, B0); PG8_MMA(0, 1, At, B1); PG8_BAR; PG8_SCHED;
            PG8_LDA(At, 1, 1); PG8_STAGE(PG8_SB(1, 0), b3, voffB); PG8_STAGE(PG8_SB(1, 1), b3 + hstepB, voffB); PG8_STAGE(PG8_SA(1, 0), a3, voffA);
            PG8_WAIT_V(8); PG8_WAIT_L(0); PG8_BAR; PG8_MMA(1, 0, At, B0); PG8_MMA(1, 1, At, B1); PG8_BAR; PG8_SCHED;
        }
        if constexpr (ALIGN_EPI) { if (wr == 0) PG8_BAR; }
        E(acc, cur, wr, wc, fr, fq);
        if (!has_next) break;
#pragma unroll
        for (int a = 0; a < 2; ++a)
#pragma unroll
            for (int b = 0; b < 2; ++b)
#pragma unroll
                for (int m = 0; m < 4; ++m)
#pragma unroll
                    for (int n = 0; n < 2; ++n) acc[a][b][m][n] = (f32x4){0.f, 0.f, 0.f, 0.f};
        cur = nxt; cB = nB; ++ui;
        if constexpr (ALIGN_EPI) { if (wr == 1) PG8_BAR; }
    }
    PG8_WAIT_V(0);
    if constexpr (!ALIGN_EPI) { if (wr == 0) PG8_BAR; }
    PG8_BAR;
#undef PG8_SA
#undef PG8_SB
#undef PG8_STAGE
#undef PG8_LDA
#undef PG8_LDB
#undef PG8_MMA
#undef PG8_WAIT_V
#undef PG8_WAIT_L
#undef PG8_BAR
#undef PG8_SCHED
}
}

constexpr int NWAVES = 8;
constexpr int BATCH = 2, SEQ = 8192, D = 1024, M = BATCH * SEQ, DEPTH = 2, PLED = 256, DFF = 2816, NIN = 8192;
constexpr float EPS = 1e-6f;
constexpr int N_IN = 25;
enum { I_X = 0, I_P, I_GMIXPRE, I_WIN, I_WSGUS, I_BSGUS, I_GSGUV, I_BSGUV, I_WSGUOUT, I_WDW, I_BDW, I_GCONVLN, I_BCONVLN, I_WCONVOUT, I_WPOOL, I_SPOOL, I_WPOOLOUT,
       I_WOUT, I_GMIXPOST, I_GFFNPRE, I_WFFNIN, I_WFFNOUT, I_GFFNPOST, I_WPLE, I_WPLEGATE };

constexpr size_t MiB = 1u << 20, KiB = 1024;
constexpr size_t WS_CTL = 0, CTL_ZERO_BYTES = 256 * KiB;
constexpr size_t WS_W = 1 * MiB;
constexpr size_t WS_W1A = WS_W, WS_W1B = WS_W + 10 * MiB, WS_WMIX = WS_W + 16 * MiB, WS_WOUT = WS_W + 22 * MiB, WS_WF1 = WS_W + 24 * MiB, WS_WF2 = WS_W + 35 * MiB,
                 WS_WPG = WS_WF2 + (size_t)D * DFF * 2, WS_WPLE = WS_WPG + 2 * MiB, WS_WPL = WS_WPLE + 512 * KiB, WS_WSGU = WS_WPL + 512 * KiB;
static_assert(WS_WSGU + 256 * KiB <= 45 * MiB, "weight region");
constexpr size_t SLOT = 32 * MiB;
constexpr size_t WS_HB0 = 45 * MiB, WS_S0 = WS_HB0 + SLOT, WS_S1 = WS_S0 + SLOT, WS_S2 = WS_S1 + SLOT, WS_S3 = WS_S2 + SLOT, WS_S4 = WS_S3 + SLOT, WS_S5 = WS_S4 + SLOT;
constexpr size_t WS_MISC = WS_S5 + SLOT;
constexpr size_t WS_VSTP = WS_MISC;
constexpr size_t WS_RS = 256 * KiB, WS_RS2 = 320 * KiB;
constexpr size_t WS_END = WS_MISC + 2 * MiB;
static_assert(WS_END <= 284508160ull, "workspace map exceeds the guaranteed d_ws size");

constexpr int RING_BYTES = 131072;
constexpr int LDSCTL_OFF = RING_BYTES, MISC_OFF = LDSCTL_OFF + 320;
constexpr int LDS_BYTES = 147456;

#define GAS __attribute__((address_space(1)))
#define LAS __attribute__((address_space(3)))
typedef unsigned short bf16;
typedef unsigned v4u __attribute__((ext_vector_type(4)));
typedef unsigned v2u __attribute__((ext_vector_type(2)));
typedef float f32x4 __attribute__((ext_vector_type(4)));
typedef float f32x2 __attribute__((ext_vector_type(2)));
typedef GAS unsigned gu32;
#define RLX_AGENT __ATOMIC_RELAXED, __HIP_MEMORY_SCOPE_AGENT
#define LDS_WAIT() asm volatile("s_waitcnt lgkmcnt(0)" ::: "memory")
#define VM_WAIT() asm volatile("s_waitcnt vmcnt(0)" ::: "memory")
__device__ __forceinline__ unsigned f2bf(float f) { unsigned u = __builtin_bit_cast(unsigned, f); return (u + 0x7fffu + ((u >> 16) & 1u)) >> 16; }
__device__ __forceinline__ unsigned pk2(float lo, float hi) { return f2bf(lo) | (f2bf(hi) << 16); }
__device__ __forceinline__ float bflo(unsigned w) { return __uint_as_float(w << 16); }
__device__ __forceinline__ float bfhi(unsigned w) { return __uint_as_float(w & 0xffff0000u); }

#define XB_TMO      128
#define XB_XCNT(j)  (256  + 64 * (j))
#define XB_XSUB(j)  (1280 + 64 * (j))
#define XB_XGEN(j)  (2304 + 64 * (j))
#define XB_TOP      3328
#define XB_TOPGEN   3392
#define XCD_BAR_WORDS 3456
#define XB_SPIN_CAP (1u << 22)
constexpr int CW_BAR = 4096;
__device__ __forceinline__ unsigned xb_ld(unsigned* p)              { return __hip_atomic_load(p, __ATOMIC_RELAXED, __HIP_MEMORY_SCOPE_AGENT); }
__device__ __forceinline__ unsigned xb_add(unsigned* p, unsigned v) { return __hip_atomic_fetch_add(p, v, __ATOMIC_RELAXED, __HIP_MEMORY_SCOPE_AGENT); }
__device__ __forceinline__ unsigned xb_xcc_id() { return (unsigned)__builtin_amdgcn_s_getreg((3 << 11) | 20) & 0xFu; }
#define XB_SPIN(cond, bar) do { unsigned _sp = 0; while (cond) { __builtin_amdgcn_s_sleep(1); \
    if ((++_sp & 255u) == 0u) { if (xb_ld(&(bar)[XB_TMO])) break; if (_sp > XB_SPIN_CAP) { atomicAdd(&(bar)[XB_TMO], 1u); break; } } } } while (0)
struct XcdBarrier { unsigned* bar; unsigned x; volatile LAS unsigned* st; };
__device__ __forceinline__ XcdBarrier xcd_barrier_post(unsigned* bar, volatile LAS unsigned* st) {
    XcdBarrier b; b.bar = bar; b.x = xb_xcc_id(); b.st = st;
    if (threadIdx.x == 0) (void)xb_add(&bar[XB_XCNT(b.x)], 1u);
    return b;
}
__device__ __forceinline__ void xcd_barrier_complete(unsigned* bar, unsigned x, unsigned& nloc, unsigned& nx) {
    const unsigned G = gridDim.x * gridDim.y * gridDim.z;
    unsigned sum, cnt, mine, sp = 0u;
    for (;;) {
        sum = 0u; cnt = 0u; mine = 0u;
#pragma unroll
        for (unsigned j = 0; j < 16; ++j) { const unsigned c = xb_ld(&bar[XB_XCNT(j)]); sum += c; cnt += (c > 0u) ? 1u : 0u; mine = (j == x) ? c : mine; }
        if (sum == G) break;
        __builtin_amdgcn_s_sleep(1);
        if ((++sp & 255u) == 0u) { if (xb_ld(&bar[XB_TMO])) break; if (sp > XB_SPIN_CAP) { atomicAdd(&bar[XB_TMO], 1u); break; } }
    }
    nloc = mine > 0u ? mine : 1u; nx = cnt > 0u ? cnt : 1u;
}
__device__ __forceinline__ void xcd_barrier(const XcdBarrier& b) {
    asm volatile("s_waitcnt vmcnt(0)" ::: "memory");
    __syncthreads();
    if (threadIdx.x == 0) {
        unsigned* bar = b.bar;
        __builtin_amdgcn_s_waitcnt(0);
        unsigned nloc = b.st[0], nx = b.st[1];
        if (nloc == 0u) { xcd_barrier_complete(bar, b.x, nloc, nx); b.st[0] = nloc; b.st[1] = nx; }
        const unsigned old = xb_add(&bar[XB_XSUB(b.x)], 1u);
        const unsigned gen = old / nloc;
        if (old + 1u == (gen + 1u) * nloc) {
            __builtin_amdgcn_fence(__ATOMIC_RELEASE, "agent");
            asm volatile("s_waitcnt vmcnt(0)" ::: "memory");
            const unsigned og = xb_add(&bar[XB_TOP], 1u);
            const unsigned tg = og / nx;
            if (og + 1u == (tg + 1u) * nx) xb_add(&bar[XB_TOPGEN], 1u);
            else XB_SPIN(xb_ld(&bar[XB_TOPGEN]) == tg, bar);
            __builtin_amdgcn_fence(__ATOMIC_ACQUIRE, "agent");
            xb_add(&bar[XB_XGEN(b.x)], 1u);
            asm volatile("s_waitcnt vmcnt(0)" ::: "memory");
        } else {
            XB_SPIN(xb_ld(&bar[XB_XGEN(b.x)]) == gen, bar);
            __builtin_amdgcn_fence(__ATOMIC_ACQUIRE, "agent");
            asm volatile("s_waitcnt vmcnt(0)" ::: "memory");
        }
    }
    __syncthreads();
}

struct Frame {
    LAS unsigned char* lds;
    volatile LAS unsigned* MISC;
    gu32* ctl;
    int tid, lane, wave;
    int vcu, G;
    const float* in[N_IN];
    float* out;
    unsigned char* ws;
};
__device__ __forceinline__ float wave_sum(float v) {
#pragma unroll
    for (int o = 1; o < 64; o <<= 1) v += __shfl_xor(v, o);
    return v;
}

__device__ __forceinline__ void tr_item(const float* W, int ldw, int k0, int scol0, bf16* WT, int ldt, int drow0, int dk0, const float* ks, const float* ns, LAS float* scr, int lane) {
#pragma unroll 8
    for (int i = 0; i < 32; ++i) { const int kk = 2 * i + (lane >> 5); float v = W[(size_t)(k0 + kk) * ldw + scol0 + (lane & 31)]; if (ks) v *= ks[k0 + kk]; scr[kk * 33 + (lane & 31)] = v; }
    LDS_WAIT(); asm volatile("" ::: "memory");
    const int c = lane & 7;
#pragma unroll
    for (int j = 0; j < 4; ++j) { const int n = (lane >> 3) + 8 * j; const LAS float* s = scr + (8 * c) * 33 + n; const float sc = ns ? ns[drow0 + n] : 1.0f;
        v4u o; o.x = pk2(s[0 * 33] * sc, s[1 * 33] * sc); o.y = pk2(s[2 * 33] * sc, s[3 * 33] * sc); o.z = pk2(s[4 * 33] * sc, s[5 * 33] * sc); o.w = pk2(s[6 * 33] * sc, s[7 * 33] * sc);
        *(v4u*)(WT + (size_t)(drow0 + n) * ldt + dk0 + k0 + 8 * c) = o; }
    LDS_WAIT(); asm volatile("" ::: "memory");
}
__device__ __forceinline__ void row_to_bf16_rs(const float* xrow, bf16* orow, float* rs, int lane) {
    const f32x4* xr = (const f32x4*)xrow + lane;
    f32x4 v[4]; float s = 0.f;
#pragma unroll
    for (int j = 0; j < 4; ++j) { v[j] = xr[64 * j]; s += (v[j].x * v[j].x + v[j].y * v[j].y) + (v[j].z * v[j].z + v[j].w * v[j].w); }
    s = wave_sum(s);
    if (rs && lane == 0) *rs = 1.0f / sqrtf(s * (1.f / D) + EPS);
    unsigned long long* o8 = (unsigned long long*)orow + lane;
#pragma unroll
    for (int j = 0; j < 4; ++j) o8[64 * j] = (unsigned long long)pk2(v[j].x, v[j].y) | ((unsigned long long)pk2(v[j].z, v[j].w) << 32);
}

__device__ __forceinline__ void ph_prep(Frame& F, int l) {
    LAS float* scr = (LAS float*)(F.lds + F.wave * 16384);
    const int gw = F.vcu * NWAVES + F.wave, NGW = F.G * NWAVES, lane = F.lane;
    const float* w_in = F.in[I_WIN] + (size_t)l * D * NIN; const float* gpre = F.in[I_GMIXPRE] + l * D;
    const float* w_so = F.in[I_WSGUOUT] + (size_t)l * D * D; const float* w_co = F.in[I_WCONVOUT] + (size_t)l * D * D; const float* w_po = F.in[I_WPOOLOUT] + (size_t)l * D * D;
    const float* w_out = F.in[I_WOUT] + (size_t)l * D * D; const float* w_f1 = F.in[I_WFFNIN] + (size_t)l * D * 2 * DFF; const float* gf = F.in[I_GFFNPRE] + l * D;
    const float* w_f2 = F.in[I_WFFNOUT] + (size_t)l * DFF * D; const float* w_pg = F.in[I_WPLEGATE] + (size_t)l * D * D; const float* w_ple = F.in[I_WPLE] + (size_t)l * PLED * D;
    const float* w_pool = F.in[I_WPOOL] + (size_t)l * 4 * 256 * 256; const float* s_pool = F.in[I_SPOOL] + l * D;
    bf16* W1A = (bf16*)(F.ws + WS_W1A); bf16* W1B = (bf16*)(F.ws + WS_W1B); bf16* WMIX = (bf16*)(F.ws + WS_WMIX); bf16* WOUT = (bf16*)(F.ws + WS_WOUT);
    bf16* WF1 = (bf16*)(F.ws + WS_WF1); bf16* WF2 = (bf16*)(F.ws + WS_WF2); bf16* WPG = (bf16*)(F.ws + WS_WPG); bf16* WPLE = (bf16*)(F.ws + WS_WPLE); bf16* WPL = (bf16*)(F.ws + WS_WPL);
    constexpr int NI = 2560 + 1536 + 1536 + 512 + 2816 + 1408 + 512 + 128 + 128;
    for (int it = gw; it < NI; it += NGW) {
        int r = it;
        if (r < 2560) { const int kb = r / 160, nb = r % 160, d0 = nb * 32; int sc;
            if (d0 < 2048 || d0 >= 4096) sc = d0; else { const int j = (d0 - 2048) >> 8, rr = (d0 - 2048) & 255; sc = rr < 128 ? 2048 + 128 * j + rr : 3072 + 128 * j + rr - 128; }
            tr_item(w_in, NIN, kb * 64, sc, W1A, D, d0, 0, gpre, nullptr, scr, lane); continue; } r -= 2560;
        if (r < 1536) { const int kb = r / 96, nb = r % 96; tr_item(w_in, NIN, kb * 64, 5120 + nb * 32, W1B, D, nb * 32, 0, gpre, nullptr, scr, lane); continue; } r -= 1536;
        if (r < 1536) { const int s = r / 512, rr = r % 512, kb = rr / 32, nb = rr % 32; const float* src = s == 0 ? w_so : (s == 1 ? w_co : w_po);
            tr_item(src, D, kb * 64, nb * 32, WMIX, 3 * D, nb * 32, s * D, nullptr, nullptr, scr, lane); continue; } r -= 1536;
        if (r < 512) { const int kb = r / 32, nb = r % 32; tr_item(w_out, D, kb * 64, nb * 32, WOUT, D, nb * 32, 0, nullptr, nullptr, scr, lane); continue; } r -= 512;
        if (r < 2816) { const int kb = r / 176, nb = r % 176, d0 = nb * 32, j = d0 >> 8, rr = d0 & 255; const int sc = rr < 128 ? 128 * j + rr : DFF + 128 * j + rr - 128;
            tr_item(w_f1, 2 * DFF, kb * 64, sc, WF1, D, d0, 0, gf, nullptr, scr, lane); continue; } r -= 2816;
        if (r < 1408) { const int kb = r / 32, nb = r % 32; tr_item(w_f2, D, kb * 64, nb * 32, WF2, DFF, nb * 32, 0, nullptr, nullptr, scr, lane); continue; } r -= 1408;
        if (r < 512) { const int kb = r / 32, nb = r % 32; tr_item(w_pg, D, kb * 64, nb * 32, WPG, D, nb * 32, 0, nullptr, nullptr, scr, lane); continue; } r -= 512;
        if (r < 128) { const int kb = r / 32, nb = r % 32; tr_item(w_ple, D, kb * 64, nb * 32, WPLE, PLED, nb * 32, 0, nullptr, nullptr, scr, lane); continue; } r -= 128;
        { const int gidx = r / 32, rr = r % 32, kb = rr / 8, nb = rr % 8; tr_item(w_pool + (size_t)gidx * 65536, 256, kb * 64, nb * 32, WPL, 256, gidx * 256 + nb * 32, 0, nullptr, s_pool, scr, lane); }
    }
    { const float* ws = F.in[I_WSGUS] + (size_t)l * 8 * 128 * 128; bf16* o = (bf16*)(F.ws + WS_WSGU);
      for (int e = F.vcu * 512 + F.tid; e < 8 * 128 * 128; e += F.G * 512) { const int i = (e >> 7) & 127, j = e & 127; float v = ws[e]; if ((j >> 6) > (i >> 6)) v = 0.f; o[e] = (bf16)f2bf(v); } }
    if (l == 0) { bf16* HB = (bf16*)(F.ws + WS_HB0); float* rs = (float*)(F.ws + WS_RS);
        for (int m = gw; m < M; m += NGW) row_to_bf16_rs(F.in[I_X] + (size_t)m * D, HB + (size_t)m * D, rs + m, lane); }
}

__device__ __forceinline__ void conv_unit(Frame& F, int l, int unit, const bf16* HC, bf16* OUT) {
    const int t0 = unit * 8, tpos0 = t0 & (SEQ - 1), c0 = 2 * F.tid;
    const float* wdw = F.in[I_WDW] + (size_t)l * 31 * D;
    f32x2 w[31];
#pragma unroll
    for (int k = 0; k < 31; ++k) w[k] = *(const f32x2*)(wdw + k * D + c0);
    const f32x2 bd = *(const f32x2*)(F.in[I_BDW] + l * D + c0);
    f32x2 acc[8];
#pragma unroll
    for (int o = 0; o < 8; ++o) acc[o] = bd;
#pragma unroll
    for (int r = 0; r < 38; ++r) {
        f32x2 x = {0.f, 0.f};
        if (tpos0 - 30 + r >= 0) { const unsigned v = *(const unsigned*)(HC + (size_t)(t0 - 30 + r) * D + c0); x.x = bflo(v); x.y = bfhi(v); }
#pragma unroll
        for (int o = 0; o < 8; ++o) { const int k = r - o; if (k >= 0 && k <= 30) acc[o] += w[k] * x; }
    }
    LAS float* red = (LAS float*)F.lds;
    float p[16];
#pragma unroll
    for (int o = 0; o < 8; ++o) { p[2 * o] = wave_sum(acc[o].x + acc[o].y); p[2 * o + 1] = wave_sum(acc[o].x * acc[o].x + acc[o].y * acc[o].y); }
    if (F.lane == 0) {
#pragma unroll
        for (int i = 0; i < 16; ++i) red[F.wave * 16 + i] = p[i]; }
    __syncthreads();
    if (F.tid < 16) { float s = 0.f;
#pragma unroll
        for (int w8 = 0; w8 < 8; ++w8) s += red[w8 * 16 + F.tid];
        red[128 + F.tid] = s; }
    __syncthreads();
    const f32x2 gl = *(const f32x2*)(F.in[I_GCONVLN] + l * D + c0), bl = *(const f32x2*)(F.in[I_BCONVLN] + l * D + c0);
#pragma unroll
    for (int o = 0; o < 8; ++o) { const float mu = red[128 + 2 * o] * (1.f / D); const float var = red[128 + 2 * o + 1] * (1.f / D) - mu * mu; const float rstd = 1.0f / sqrtf(fmaxf(var, 0.f) + EPS);
        float y0 = (acc[o].x - mu) * rstd * gl.x + bl.x, y1 = (acc[o].y - mu) * rstd * gl.y + bl.y;
        y0 = y0 * pg8::sigmoidf_fast(y0); y1 = y1 * pg8::sigmoidf_fast(y1);
        *(unsigned*)(OUT + (size_t)(t0 + o) * D + c0) = pk2(y0, y1); }
    __syncthreads();
}
template <int W>
__device__ __forceinline__ void pool_item(const bf16* ZP, bf16* PO, int chunk, int g, int lane) {
    const int t0 = chunk * 16, tpos0 = t0 & (SEQ - 1), col = g * 256 + 4 * lane;
    constexpr int NR = 16 + W - 1;
    v2u x[NR];
#pragma unroll
    for (int r = 0; r < NR; ++r) { if (tpos0 - (W - 1) + r >= 0) x[r] = *(const v2u*)(ZP + (size_t)(t0 - (W - 1) + r) * D + col); else x[r] = (v2u){0u, 0u}; }
#pragma unroll
    for (int o = 0; o < 16; ++o) { float s0 = 0.f, s1 = 0.f, s2 = 0.f, s3 = 0.f;
#pragma unroll
        for (int j = 0; j < W; ++j) { const v2u v = x[o + W - 1 - j]; s0 += bflo(v.x); s1 += bfhi(v.x); s2 += bflo(v.y); s3 += bfhi(v.y); }
        const int cnt = (tpos0 + o + 1) < W ? (tpos0 + o + 1) : W; const float inv = 1.0f / (float)cnt; const v2u z = x[o + W - 1];
        v2u ov; ov.x = pk2(s0 * inv - bflo(z.x), s1 * inv - bfhi(z.x)); ov.y = pk2(s2 * inv - bflo(z.y), s3 * inv - bfhi(z.y));
        *(v2u*)(PO + (size_t)(t0 + o) * D + col) = ov; }
}
typedef short v4i16_t __attribute__((ext_vector_type(4)));
typedef short bf16x8v __attribute__((ext_vector_type(8)));
__device__ __forceinline__ void sgu_unit(Frame& F, int l, int unit, bf16* U, const bf16* V, const float* VSTP) {
    const int nb = unit >> 3, h = unit & 7, t0 = nb * 128, c0 = h * 128, tid = F.tid, lane = F.lane, w = F.wave;
    LAS f32x2* ST = (LAS f32x2*)F.lds; LAS unsigned char* VL = F.lds + 1024; LAS unsigned char* WM = F.lds + 1024 + 34816;
    if (tid < 128) { const f32x4* pp = (const f32x4*)(VSTP + (size_t)(t0 + tid) * 32); float s1 = 0.f, s2 = 0.f;
#pragma unroll
        for (int k = 0; k < 8; ++k) { const f32x4 v = pp[k]; s1 += v.x + v.z; s2 += v.y + v.w; }
        const float mu = s1 * (1.f / D), var = s2 * (1.f / D) - mu * mu; ST[tid] = (f32x2){mu, 1.0f / sqrtf(fmaxf(var, 0.f) + EPS)}; }
    { const bf16* wsrc = (const bf16*)(F.ws + WS_WSGU) + (size_t)h * 128 * 128;
      for (int e = tid; e < 2048; e += 512) { const int i = e >> 4, ch = e & 15; const v4u q = *(const v4u*)(wsrc + i * 128 + ch * 8); *(LAS v4u*)(WM + i * 272 + ch * 16) = q; } }
    __syncthreads();
    { const float* gv = F.in[I_GSGUV] + l * D + c0; const float* bv = F.in[I_BSGUV] + l * D + c0;
      for (int e = tid; e < 2048; e += 512) { const int j = e >> 4, c8 = (e & 15) * 8; const v4u q = *(const v4u*)(V + (size_t)(t0 + j) * D + c0 + c8); const f32x2 st = ST[j];
          const f32x4 g0 = *(const f32x4*)(gv + c8), g1 = *(const f32x4*)(gv + c8 + 4), b0 = *(const f32x4*)(bv + c8), b1 = *(const f32x4*)(bv + c8 + 4);
          v4u o; o.x = pk2((bflo(q.x) - st.x) * st.y * g0.x + b0.x, (bfhi(q.x) - st.x) * st.y * g0.y + b0.y); o.y = pk2((bflo(q.y) - st.x) * st.y * g0.z + b0.z, (bfhi(q.y) - st.x) * st.y * g0.w + b0.w);
          o.z = pk2((bflo(q.z) - st.x) * st.y * g1.x + b1.x, (bfhi(q.z) - st.x) * st.y * g1.y + b1.y); o.w = pk2((bflo(q.w) - st.x) * st.y * g1.z + b1.z, (bfhi(q.w) - st.x) * st.y * g1.w + b1.w);
          *(LAS v4u*)(VL + j * 272 + c8 * 2) = o; } }
    __syncthreads();
    const int fr = lane & 15, fq = lane >> 4, q4 = (lane & 15) >> 2, p4 = lane & 3;
    f32x4 acc[8];
#pragma unroll
    for (int c = 0; c < 8; ++c) acc[c] = (f32x4){0.f, 0.f, 0.f, 0.f};
#pragma unroll
    for (int ks = 0; ks < 4; ++ks) {
        const bf16x8v bfr = *(const LAS bf16x8v*)(WM + (16 * w + fr) * 272 + (32 * ks + 8 * fq) * 2);
#pragma unroll
        for (int c = 0; c < 8; ++c) {
            const v4i16_t lo = __builtin_amdgcn_ds_read_tr16_b64_v4i16((LAS v4i16_t*)(VL + (32 * ks + 8 * fq + q4) * 272 + (16 * c + 4 * p4) * 2));
            const v4i16_t hi = __builtin_amdgcn_ds_read_tr16_b64_v4i16((LAS v4i16_t*)(VL + (32 * ks + 8 * fq + 4 + q4) * 272 + (16 * c + 4 * p4) * 2));
            const bf16x8v afr = __builtin_shufflevector(lo, hi, 0, 1, 2, 3, 4, 5, 6, 7);
            acc[c] = __builtin_amdgcn_mfma_f32_16x16x32_bf16(afr, bfr, acc[c], 0, 0, 0);
        }
    }
    { const int i = 16 * w + fr; const float bias = F.in[I_BSGUS][(l * 8 + h) * 128 + i];
#pragma unroll
      for (int c = 0; c < 8; ++c) { v2u* up = (v2u*)(U + (size_t)(t0 + i) * D + c0 + 16 * c + 4 * fq); const v2u uu = *up; v2u o;
          o.x = pk2(bflo(uu.x) * (acc[c][0] + bias), bfhi(uu.x) * (acc[c][1] + bias)); o.y = pk2(bflo(uu.y) * (acc[c][2] + bias), bfhi(uu.y) * (acc[c][3] + bias)); *up = o; } }
    __syncthreads();
}
__device__ __forceinline__ void ph_mix(Frame& F, int l) {
    bf16* U = (bf16*)(F.ws + WS_S0); const bf16* V = (const bf16*)(F.ws + WS_S1); const bf16* HC = (const bf16*)(F.ws + WS_S2); const bf16* ZP = (const bf16*)(F.ws + WS_S3);
    bf16* ACTB = (bf16*)(F.ws + WS_S4); bf16* PO = (bf16*)(F.ws + WS_S5); const float* VSTP = (const float*)(F.ws + WS_VSTP);
    for (int u = F.vcu; u < M / 8; u += F.G) conv_unit(F, l, u, HC, ACTB);
    for (int u = F.vcu; u < 1024; u += F.G) sgu_unit(F, l, u, U, V, VSTP);
    const int gw = F.vcu * NWAVES + F.wave, NGW = F.G * NWAVES;
    for (int it = gw; it < 4096; it += NGW) { const int chunk = it >> 2, g = it & 3;
        if (g == 0) pool_item<2>(ZP, PO, chunk, 0, F.lane); else if (g == 1) pool_item<4>(ZP, PO, chunk, 1, F.lane); else if (g == 2) pool_item<8>(ZP, PO, chunk, 2, F.lane); else pool_item<16>(ZP, PO, chunk, 3, F.lane); }
}
__device__ __forceinline__ void ph_rows_norm(Frame& F, const float* Y, const float* base, const float* gain, bf16* HB, float* rs_out) {
    const int gw = F.vcu * NWAVES + F.wave, NGW = F.G * NWAVES, lane = F.lane;
    for (int m = gw; m < M; m += NGW) {
        const f32x4* yr = (const f32x4*)(Y + (size_t)m * D) + lane; const f32x4* br = (const f32x4*)(base + (size_t)m * D) + lane; const f32x4* gr = (const f32x4*)gain + lane;
        f32x4 y[4]; float s = 0.f;
#pragma unroll
        for (int j = 0; j < 4; ++j) { y[j] = yr[64 * j]; s += (y[j].x * y[j].x + y[j].y * y[j].y) + (y[j].z * y[j].z + y[j].w * y[j].w); }
        const float rstd = 1.0f / sqrtf(wave_sum(s) * (1.f / D) + EPS); float s2 = 0.f;
        f32x4* orow = (f32x4*)(F.out + (size_t)m * D) + lane; unsigned long long* o8 = (unsigned long long*)(HB + (size_t)m * D) + lane;
#pragma unroll
        for (int j = 0; j < 4; ++j) { const f32x4 hn = br[64 * j] + y[j] * rstd * gr[64 * j]; orow[64 * j] = hn; s2 += (hn.x * hn.x + hn.y * hn.y) + (hn.z * hn.z + hn.w * hn.w);
            o8[64 * j] = (unsigned long long)pk2(hn.x, hn.y) | ((unsigned long long)pk2(hn.z, hn.w) << 32); }
        if (rs_out) { s2 = wave_sum(s2); if (lane == 0) rs_out[m] = 1.0f / sqrtf(s2 * (1.f / D) + EPS); }
    }
}

enum { PH_PREP = 0, PH_G1A, PH_MIX, PH_G1B, PH_MERGE, PH_WOUT, PH_ROWS1, PH_FFN1, PH_FFN2, PH_ROWS2, PH_PLE, PH_ROWS3, NPH };
constexpr int N_PHASES = DEPTH * NPH - 1;
struct Args { const float* in[N_IN]; float* out; unsigned char* ws; int ph_lo, ph_hi; };
static_assert(sizeof(Args) == N_IN * 8 + 24, "Args has no padding");

__global__ void __launch_bounds__(NWAVES * 64, 2) mega(Args args) {
    extern __shared__ __attribute__((aligned(16))) unsigned char lds_raw[];
    Frame F;
    F.lds = (LAS unsigned char*)lds_raw;
    F.MISC = (volatile LAS unsigned*)(F.lds + MISC_OFF);
    F.tid = threadIdx.x; F.lane = F.tid & 63; F.wave = __builtin_amdgcn_readfirstlane(F.tid >> 6);
    F.G = gridDim.x; { const int bx = blockIdx.x; F.vcu = (F.G % 8 == 0) ? (bx % 8) * (F.G / 8) + bx / 8 : bx; }
    F.ws = args.ws; F.out = args.out; F.ctl = (gu32*)(args.ws + WS_CTL);
#pragma unroll
    for (int i = 0; i < N_IN; ++i) F.in[i] = args.in[i];
    for (int u = F.tid; u < (LDS_BYTES - LDSCTL_OFF) / 4; u += NWAVES * 64) ((LAS unsigned*)(F.lds + LDSCTL_OFF))[u] = 0u;
    __syncthreads();
    XcdBarrier bar; bar.bar = (unsigned*)(F.ctl + CW_BAR); bar.x = 0; bar.st = nullptr;
    const bool multi = (args.ph_hi - args.ph_lo) > 1;
    if (multi) bar = xcd_barrier_post((unsigned*)(F.ctl + CW_BAR), F.MISC + 8);

    unsigned char* ws = F.ws;
    const size_t TS = (size_t)M * D;

    for (int ph = args.ph_lo; ph < args.ph_hi; ++ph) {
        { int t_ = threadIdx.x; asm volatile("" : "+v"(t_)); F.tid = t_; F.lane = t_ & 63; F.wave = __builtin_amdgcn_readfirstlane(t_ >> 6);
          unsigned long long w_ = (unsigned long long)args.ws; asm volatile("" : "+s"(w_)); ws = (unsigned char*)(GAS unsigned char*)w_; F.ws = ws; }
        bf16* HB0 = (bf16*)(ws + WS_HB0); bf16* S0 = (bf16*)(ws + WS_S0); bf16* S1 = (bf16*)(ws + WS_S1); bf16* S2 = (bf16*)(ws + WS_S2); bf16* S3 = (bf16*)(ws + WS_S3);
        bf16* S4 = (bf16*)(ws + WS_S4); bf16* S5 = (bf16*)(ws + WS_S5);
        float* RS = (float*)(ws + WS_RS); float* RS2 = (float*)(ws + WS_RS2);
        const int l = ph / NPH, k = ph % NPH;
        if (k == PH_PREP) ph_prep(F, l);
        if (k == PH_G1A) {
            pg8::Gemm g{HB0, nullptr, nullptr, (const bf16*)(ws + WS_W1A), D, D, M, 5120, D, 0}; pg8::StaticOrder S; S.init(M, 5120, F.G, (int)blockIdx.x);
            pg8::EpiG1a E{S0, S1, S2, S3, RS, (float*)(ws + WS_VSTP)};
            pg8::gemm_phase<pg8::EpiG1a, true, false>(F.lds, g, S, E, F.tid);
        }
        if (k == PH_MIX) ph_mix(F, l);
        if (k == PH_G1B) {
            pg8::Gemm g{HB0, nullptr, nullptr, (const bf16*)(ws + WS_W1B), D, D, M, 3072, D, 0}; pg8::StaticOrder S; S.init(M, 3072, F.G, (int)blockIdx.x);
            pg8::EpiGate E{S1, RS, TS};
            pg8::gemm_phase<pg8::EpiGate, true, false>(F.lds, g, S, E, F.tid);
        }
        if (k == PH_MERGE) {
            pg8::Gemm g{S0, S4, S5, (const bf16*)(ws + WS_WMIX), D, 3 * D, M, D, 3 * D, 0}; pg8::StaticOrder S; S.init(M, D, F.G, (int)blockIdx.x);
            pg8::EpiMerged E{HB0, S1, TS};
            pg8::gemm_phase<pg8::EpiMerged, false, true>(F.lds, g, S, E, F.tid);
        }
        if (k == PH_WOUT || k == PH_FFN2) {
            pg8::Gemm g; pg8::EpiF32 E;
            if (k == PH_WOUT) { g = pg8::Gemm{HB0, nullptr, nullptr, (const bf16*)(ws + WS_WOUT), D, D, M, D, D, 0}; E = pg8::EpiF32{(float*)S1, D}; }
            else { g = pg8::Gemm{S1, nullptr, nullptr, (const bf16*)(ws + WS_WF2), DFF, DFF, M, D, DFF, 0}; E = pg8::EpiF32{(float*)S4, D}; }
            pg8::StaticOrder S; S.init(M, D, F.G, (int)blockIdx.x);
            pg8::gemm_phase<pg8::EpiF32, false, false>(F.lds, g, S, E, F.tid);
            if (k == PH_WOUT) {
                const f32x4* pp = (const f32x4*)(F.in[I_P] + (size_t)l * M * PLED); v2u* po = (v2u*)S4;
                for (int e = F.vcu * 512 + F.tid; e < M * PLED / 4; e += F.G * 512) { const f32x4 v = pp[e]; v2u o; o.x = pk2(v.x, v.y); o.y = pk2(v.z, v.w); po[e] = o; } }
        }
        if (k == PH_ROWS1) ph_rows_norm(F, (const float*)S1, l == 0 ? F.in[I_X] : F.out, F.in[I_GMIXPOST] + l * D, S0, RS2);
        if (k == PH_FFN1) {
            pg8::Gemm g{S0, nullptr, nullptr, (const bf16*)(ws + WS_WF1), D, D, M, 2 * DFF, D, 0}; pg8::StaticOrder S; S.init(M, 2 * DFF, F.G, (int)blockIdx.x);
            pg8::EpiSwiGLU E{S1, DFF, RS2};
            pg8::gemm_phase<pg8::EpiSwiGLU, true, false>(F.lds, g, S, E, F.tid);
        }
        if (k == PH_G1B || k == PH_FFN1) {
            pg8::Gemm g; pg8::EpiBf16 E; pg8::StaticOrder S;
            if (k == PH_G1B) { g = pg8::Gemm{S5, nullptr, nullptr, (const bf16*)(ws + WS_WPL), D, 256, M, D, 256, 256}; E = pg8::EpiBf16{S5, D}; S.init(M, D, F.G, (int)blockIdx.x); }
            else { g = pg8::Gemm{S4, nullptr, nullptr, (const bf16*)(ws + WS_WPLE), PLED, PLED, M, D, PLED, 0}; E = pg8::EpiBf16{HB0, D};
                   if (F.G == 256) S.init(M, D, 128, (int)blockIdx.x >= 128 ? (int)blockIdx.x - 128 : (1 << 24)); else S.init(M, D, F.G, (int)blockIdx.x); }
            pg8::gemm_phase<pg8::EpiBf16, false, false>(F.lds, g, S, E, F.tid);
        }
        if (k == PH_ROWS2) ph_rows_norm(F, (const float*)S4, F.out, F.in[I_GFFNPOST] + l * D, S0, nullptr);
        if (k == PH_PLE) {
            pg8::Gemm g{S0, nullptr, nullptr, (const bf16*)(ws + WS_WPG), D, D, M, D, D, 0}; pg8::StaticOrder S; S.init(M, D, F.G, (int)blockIdx.x);
            pg8::EpiPle E{F.out, HB0};
            pg8::gemm_phase<pg8::EpiPle, false, false>(F.lds, g, S, E, F.tid);
        }
        if (k == PH_ROWS3) { const int gw = F.vcu * NWAVES + F.wave, NGW = F.G * NWAVES;
            for (int m = gw; m < M; m += NGW) row_to_bf16_rs(F.out + (size_t)m * D, HB0 + (size_t)m * D, RS + m, F.lane); }
        if (ph + 1 < args.ph_hi) xcd_barrier(bar);
    }
}

extern "C" void kernel_launch(void* const* d_in, const int* in_sizes, int n_in, void* d_out, int out_size, void* d_ws, size_t ws_size, hipStream_t stream) {
    static int grid = 0;
    if (grid == 0) {
        if (n_in != N_IN || in_sizes[0] != M * D || out_size != M * D || ws_size < WS_END) { fprintf(stderr, "kernel_launch: unexpected shapes (n_in %d, in0 %d, out %d, ws %zu < %zu)\n", n_in, n_in > 0 ? in_sizes[0] : -1, out_size, ws_size, (size_t)WS_END); grid = -1; return; }
        int dev = 0, cus = 0, per_cu = 0;
        if (hipGetDevice(&dev) != hipSuccess || hipDeviceGetAttribute(&cus, hipDeviceAttributeMultiprocessorCount, dev) != hipSuccess) { grid = -1; return; }
        if (hipFuncSetAttribute((const void*)mega, hipFuncAttributeMaxDynamicSharedMemorySize, LDS_BYTES) != hipSuccess) { fprintf(stderr, "kernel_launch: hipFuncSetAttribute failed\n"); grid = -1; return; }
        if (hipOccupancyMaxActiveBlocksPerMultiprocessor(&per_cu, (const void*)mega, NWAVES * 64, LDS_BYTES) != hipSuccess || per_cu < 1) { fprintf(stderr, "kernel_launch: occupancy query says %d blocks per CU\n", per_cu); }
        (void)hipGetLastError();
        grid = cus;
    }
    if (grid < 0) return;
    if (hipMemsetAsync((char*)d_ws + WS_CTL, 0, CTL_ZERO_BYTES, stream) != hipSuccess) return;
    Args a{};
    for (int i = 0; i < N_IN; ++i) a.in[i] = (const float*)d_in[i];
    a.out = (float*)d_out; a.ws = (unsigned char*)d_ws;
#if MK_ONE_LAUNCH
    a.ph_lo = 0; a.ph_hi = N_PHASES;
    hipLaunchKernelGGL(mega, dim3(grid), dim3(NWAVES * 64), LDS_BYTES, stream, a);
#else
    for (int ph = 0; ph < N_PHASES; ++ph) { a.ph_lo = ph; a.ph_hi = ph + 1; hipLaunchKernelGGL(mega, dim3(grid), dim3(NWAVES * 64), LDS_BYTES, stream, a); }
#endif
}
```
